# Optimizing an MI355X kernel written in HIP

```python
import jax, jax.numpy as jnp
from jax import lax
import numpy as np

D_MODEL = 4096
BATCH = 4
SEQ = 4096
DEPTH = 1

D_MIX = D_MODEL
D_ATTN = D_MIX // 2
D_POOL = D_MIX - D_ATTN
HEAD_DIM = 128
N_ATTN_HEADS = D_ATTN // HEAD_DIM
POOL_WINDOWS = (2, 4, 8, 16)
N_POOL_GROUPS = len(POOL_WINDOWS)
POOL_GROUP = D_POOL // N_POOL_GROUPS
Q_BLOCK = 128
PEER_HEADS = 8
PEER_TOPK = 16
PEER_NKEYS = 128
PEER_NEXPERTS = PEER_NKEYS * PEER_NKEYS
PEER_DQ = 256
PEER_DHALF = PEER_DQ // 2
PEER_CHUNK = 64
N_MOD = 6
EPS = 1e-6

kernel_name = 'hybrid_stickbreak_pool_peer_adaln'


def rmsnorm(x, g):
    x32 = x.astype(jnp.float32)
    y = x32 * lax.rsqrt(jnp.mean(x32 * x32, axis=-1, keepdims=True) + EPS)
    return (y * g.astype(jnp.float32)).astype(x.dtype)


def stick_breaking_attention(q, k, v):
    S = q.shape[2]
    outs = []
    for i in range(S // Q_BLOCK):
        start = i * Q_BLOCK
        end = start + Q_BLOCK
        qb = q[:, :, start:end]
        kb = k[:, :, :end]
        vb = v[:, :, :end]
        z = jnp.einsum('bhtd,bhsd->bhts', qb, kb).astype(jnp.float32) * (HEAD_DIM ** -0.5)
        q_pos = start + jnp.arange(Q_BLOCK)
        k_pos = jnp.arange(end)
        causal = k_pos[None, :] < q_pos[:, None]
        log_not = jnp.where(causal, jax.nn.log_sigmoid(-z), 0.0)
        between = lax.cumsum(log_not, axis=3, reverse=True) - log_not
        a = jnp.where(causal, jnp.exp(jax.nn.log_sigmoid(z) + between), 0.0)
        outs.append(jnp.einsum('bhts,bhsd->bhtd', a.astype(vb.dtype), vb))
    return jnp.concatenate(outs, axis=2)


def multiscale_pool(p, w_pool, s_pool):
    B, S, _ = p.shape
    p32 = p.astype(jnp.float32)
    csum = jnp.cumsum(p32, axis=1)
    pos = jnp.arange(S)
    groups = []
    for gi, w in enumerate(POOL_WINDOWS):
        sl = slice(gi * POOL_GROUP, (gi + 1) * POOL_GROUP)
        cg = csum[..., sl]
        lagged = jnp.pad(cg, ((0, 0), (w, 0), (0, 0)))[:, :S]
        count = jnp.minimum(pos + 1, w).astype(jnp.float32)[None, :, None]
        groups.append((cg - lagged) / count - p32[..., sl])
    d = jnp.stack(groups, axis=2).astype(p.dtype)
    y = jnp.einsum('bsgc,gcd->bsgd', d, w_pool).reshape(B, S, D_POOL)
    return y * s_pool


def peer_ffn(h, w_query, sub_keys_1, sub_keys_2, u_experts, v_experts):
    B, S, D = h.shape
    q = jnp.einsum('bsd,dq->bsq', h, w_query).reshape(B, S, PEER_HEADS, PEER_DQ)
    q1 = q[..., :PEER_DHALF]
    q2 = q[..., PEER_DHALF:]
    s1 = jnp.einsum('bshc,nc->bshn', q1, sub_keys_1).astype(jnp.float32)
    s2 = jnp.einsum('bshc,nc->bshn', q2, sub_keys_2).astype(jnp.float32)
    v1, i1 = lax.top_k(s1, PEER_TOPK)
    v2, i2 = lax.top_k(s2, PEER_TOPK)
    cand_s = (v1[..., :, None] + v2[..., None, :]).reshape(B, S, PEER_HEADS, PEER_TOPK * PEER_TOPK)
    cand_i = (i1[..., :, None] * PEER_NKEYS + i2[..., None, :]).reshape(B, S, PEER_HEADS, PEER_TOPK * PEER_TOPK)
    top_s, sel = lax.top_k(cand_s, PEER_TOPK)
    idx = jnp.take_along_axis(cand_i, sel, axis=-1)
    g = jax.nn.softmax(top_s, axis=-1).astype(h.dtype)
    n_chunks = (B * S) // PEER_CHUNK
    hc = h.reshape(n_chunks, PEER_CHUNK, D)
    ic = idx.reshape(n_chunks, PEER_CHUNK, PEER_HEADS, PEER_TOPK)
    gc = g.reshape(n_chunks, PEER_CHUNK, PEER_HEADS, PEER_TOPK)

    def expert_chunk(args):
        hx, ix, gx = args
        u = jnp.take(u_experts, ix, axis=0)
        act = jax.nn.gelu(jnp.einsum('chkd,cd->chk', u, hx), approximate=False) * gx
        vv = jnp.take(v_experts, ix, axis=0)
        return jnp.einsum('chk,chkd->cd', act, vv)

    y = lax.map(expert_chunk, (hc, ic, gc))
    return y.reshape(B, S, D)


def setup_inputs(seed: int = 0) -> dict:
    key = jax.random.key(seed)
    ks = jax.random.split(key, 17)
    f32 = jnp.float32
    D = D_MODEL
    nrm = lambda k, shape, s: jax.random.normal(k, shape, f32) * s
    return {
        'x': nrm(ks[0], (BATCH, SEQ, D), 1.0),
        'c': nrm(ks[1], (BATCH, D), 1.0),
        'w_ada': nrm(ks[2], (DEPTH, D, N_MOD * D), 0.5 * D ** -0.5),
        'b_ada': nrm(ks[3], (DEPTH, N_MOD * D), 0.01),
        'g_norm1': 1.0 + nrm(ks[4], (DEPTH, D), 0.02),
        'w_in': nrm(ks[5], (DEPTH, D, 3 * D_ATTN + D_POOL), D ** -0.5),
        'g_attn_head': 1.0 + nrm(ks[6], (DEPTH, N_ATTN_HEADS, HEAD_DIM), 0.02),
        'w_pool': nrm(ks[7], (DEPTH, N_POOL_GROUPS, POOL_GROUP, POOL_GROUP), POOL_GROUP ** -0.5),
        's_pool': 1.0 + nrm(ks[8], (DEPTH, D_POOL), 0.02),
        'w_out': nrm(ks[9], (DEPTH, D_MIX, D), D_MIX ** -0.5),
        'g_norm2': 1.0 + nrm(ks[10], (DEPTH, D), 0.02),
        'w_query': nrm(ks[11], (DEPTH, D, PEER_HEADS * PEER_DQ), D ** -0.5),
        'sub_keys_1': nrm(ks[12], (DEPTH, PEER_NKEYS, PEER_DHALF), PEER_DHALF ** -0.5),
        'sub_keys_2': nrm(ks[13], (DEPTH, PEER_NKEYS, PEER_DHALF), PEER_DHALF ** -0.5),
        'u_experts': nrm(ks[14], (DEPTH, PEER_NEXPERTS, D), D ** -0.5),
        'v_experts': nrm(ks[15], (DEPTH, PEER_NEXPERTS, D), 0.5),
        'g_final': 1.0 + nrm(ks[16], (D,), 0.02),
    }


def reference(x, c, w_ada, b_ada, g_norm1, w_in, g_attn_head, w_pool, s_pool, w_out,
              g_norm2, w_query, sub_keys_1, sub_keys_2, u_experts, v_experts, g_final):
    B, S, D = x.shape
    silu_c = jax.nn.silu(c)
    for l in range(DEPTH):
        mod = (jnp.einsum('bd,dm->bm', silu_c, w_ada[l]) + b_ada[l]).reshape(B, N_MOD, 1, D)
        shift1, scale1, gate1 = mod[:, 0], mod[:, 1], mod[:, 2]
        shift2, scale2, gate2 = mod[:, 3], mod[:, 4], mod[:, 5]

        h = rmsnorm(x, g_norm1[l]) * (1.0 + scale1) + shift1
        proj = jnp.einsum('bsd,de->bse', h, w_in[l])
        q = proj[..., :D_ATTN].reshape(B, S, N_ATTN_HEADS, HEAD_DIM).transpose(0, 2, 1, 3)
        k = proj[..., D_ATTN:2 * D_ATTN].reshape(B, S, N_ATTN_HEADS, HEAD_DIM).transpose(0, 2, 1, 3)
        v = proj[..., 2 * D_ATTN:3 * D_ATTN].reshape(B, S, N_ATTN_HEADS, HEAD_DIM).transpose(0, 2, 1, 3)
        p = proj[..., 3 * D_ATTN:]
        o_attn = stick_breaking_attention(q, k, v).transpose(0, 2, 1, 3)
        o_attn = rmsnorm(o_attn, g_attn_head[l]).reshape(B, S, D_ATTN)
        o_pool = multiscale_pool(p, w_pool[l], s_pool[l])
        mix = jnp.einsum('bse,ed->bsd', jnp.concatenate([o_attn, o_pool], axis=-1), w_out[l])
        x = x + gate1 * mix

        h2 = rmsnorm(x, g_norm2[l]) * (1.0 + scale2) + shift2
        x = x + gate2 * peer_ffn(h2, w_query[l], sub_keys_1[l], sub_keys_2[l], u_experts[l], v_experts[l])
    return rmsnorm(x, g_final)
```

```cpp
#include <hip/hip_runtime.h>
#include <cstdio>
#include <cstdint>
namespace pg8 {
#define PG8_LAS __attribute__((address_space(3)))
typedef unsigned short bf16_t;
typedef short bf16x8 __attribute__((ext_vector_type(8)));
typedef float f32x4 __attribute__((ext_vector_type(4)));
typedef unsigned u32x4 __attribute__((ext_vector_type(4)));
constexpr int BM = 256, BK = 64, HALF = 128, HTB = HALF * BK * 2  , STAGE_BYTES = 8 * HTB, NXCD = 8, WGM = 8;

__host__ __device__ __forceinline__ int lds_byte(int r, int c) { const int st = (r >> 4) * 2 + (c >> 5), rr = r & 15, cc = c & 31, ob = rr * 64 + cc * 2; return st * 1024 + (ob ^ (((ob >> 9) & 1) << 5)); }
__host__ __device__ __forceinline__ void stage_rc(int b, int& R, int& C) { const int st = b / 1024, sb = b % 1024, swz = sb ^ (((sb >> 9) & 1) << 5); R = (st >> 1) * 16 + swz / 64; C = (st & 1) * 32 + (swz % 64) / 2; }
__host__ __device__ __forceinline__ int perm32(int rho) { const int n = rho >> 4, i = rho & 15; return 8 * (i >> 2) + 4 * n + (i & 3); }

struct Unit { int pm, pn; };
struct Gemm { const bf16_t* A; const bf16_t* Bt; int M, N, K; int png; size_t agb; };

struct StaticOrder {
    int nM, nN, nwg, G, c;
    __host__ __device__ void init(int M, int N, int G_, int c_) { nM = M / BM; nN = N / BM; nwg = nM * nN; G = G_; c = c_; }
    __host__ __device__ bool next(int i, Unit& u) const {
        const long L = (long)i * G + c; if (L >= nwg) return false;
        int wgid = (int)L; { const int q = nwg / NXCD, r = nwg % NXCD, xcd = wgid % NXCD, off = wgid / NXCD; wgid = (xcd < r ? xcd * (q + 1) : r * (q + 1) + (xcd - r) * q) + off; }
        const int nig = WGM * nN, gid = wgid / nig, fm = gid * WGM, gsz = (nM - fm) < WGM ? (nM - fm) : WGM;
        u.pm = fm + ((wgid % nig) % gsz); u.pn = (wgid % nig) / gsz; return true;
    }
    __device__ __forceinline__ void a_ready(const Unit&) const {}
    __device__ __forceinline__ void done(const Unit&) const {}
};

__device__ __forceinline__ unsigned cvt_pk_bf16(float lo, float hi) { unsigned r; asm volatile("v_cvt_pk_bf16_f32 %0, %1, %2" : "=v"(r) : "v"(lo), "v"(hi)); return r; }
typedef float f32x2 __attribute__((ext_vector_type(2)));
__device__ __forceinline__ f32x2 gelu_pk(f32x2 v) {
    const f32x2 av = __builtin_elementwise_abs(v), d = av * 0.2316418882f + 1.0f;
    f32x2 t; t.x = __builtin_amdgcn_rcpf(d.x); t.y = __builtin_amdgcn_rcpf(d.y);
    f32x2 q = t * 0.5307027145f + (-0.7265760135f); q = q * t + 0.7107068705f; q = q * t + (-0.142248368f); q = q * t + 0.127414796f; q = q * t;
    const f32x2 s = (v * v) * (-0.72134752044f);
    f32x2 e; e.x = __builtin_amdgcn_exp2f(s.x); e.y = __builtin_amdgcn_exp2f(s.y);
    const f32x2 m = v * (q * e), r = v - m;
    f32x2 o; o.x = v.x < 0.f ? m.x : r.x; o.y = v.y < 0.f ? m.y : r.y; return o;
}

template <int ACT  > struct EpiBf16 {
    static constexpr bool PERM = true, AFTER_DRAIN = false; static_assert(ACT == 0 || ACT == 1, "EpiBf16: ACT is 0 (none) or 1 (gelu_pk)");
    bf16_t* O; int ldc; const float* bias; int split_cols; size_t split_stride; float scale0;
    __device__ __forceinline__ void operator()(const f32x4 (&acc)[2][2][4][2], const Unit& u, int wr, int wc, int fr, int fq) const {
        const int row0 = u.pm * BM + wr * 64 + fr; int colt = u.pn * BM; bf16_t* base = O;
        float sc = 1.f; if (split_cols) { const int t = colt / split_cols; base += (size_t)t * split_stride; colt -= t * split_cols; if (t == 0) sc = scale0; }
        const int col0 = colt + wc * 32 + 8 * fq, bcol0 = u.pn * BM + wc * 32 + 8 * fq;
        f32x4 bv[2][2];
#pragma unroll
        for (int bj = 0; bj < 2; ++bj)
#pragma unroll
            for (int n = 0; n < 2; ++n) bv[bj][n] = bias ? *(const f32x4*)(bias + bcol0 + bj * HALF + 4 * n) : (f32x4){0.f, 0.f, 0.f, 0.f};
#pragma unroll
        for (int ai = 0; ai < 2; ++ai)
#pragma unroll
            for (int m = 0; m < 4; ++m) { bf16_t* rowp = base + (size_t)(row0 + ai * HALF + m * 16) * ldc + col0;
#pragma unroll
                for (int bj = 0; bj < 2; ++bj) { f32x4 v0 = acc[ai][bj][m][0] + bv[bj][0], v1 = acc[ai][bj][m][1] + bv[bj][1];
                    if (ACT == 1) { f32x2 a = gelu_pk((f32x2){v0[0], v0[1]}), b = gelu_pk((f32x2){v0[2], v0[3]}), c = gelu_pk((f32x2){v1[0], v1[1]}), d = gelu_pk((f32x2){v1[2], v1[3]});
                        v0 = (f32x4){a.x, a.y, b.x, b.y}; v1 = (f32x4){c.x, c.y, d.x, d.y}; }
                    v0 = v0 * sc; v1 = v1 * sc; u32x4 w; w.x = cvt_pk_bf16(v0[0], v0[1]); w.y = cvt_pk_bf16(v0[2], v0[3]); w.z = cvt_pk_bf16(v1[0], v1[1]); w.w = cvt_pk_bf16(v1[2], v1[3]);
                    *(u32x4*)(rowp + bj * HALF) = w; } }
    }
};
struct EpiScaleBf16 {
    static constexpr bool PERM = true, AFTER_DRAIN = false;
    bf16_t* O; int ldc; const float* cs;
    __device__ __forceinline__ void operator()(const f32x4 (&acc)[2][2][4][2], const Unit& u, int wr, int wc, int fr, int fq) const {
        const int row0 = u.pm * BM + wr * 64 + fr, col0 = u.pn * BM + wc * 32 + 8 * fq;
        f32x4 sv[2][2];
#pragma unroll
        for (int bj = 0; bj < 2; ++bj)
#pragma unroll
            for (int n = 0; n < 2; ++n) sv[bj][n] = *(const f32x4*)(cs + col0 + bj * HALF + 4 * n);
#pragma unroll
        for (int ai = 0; ai < 2; ++ai)
#pragma unroll
            for (int m = 0; m < 4; ++m) { bf16_t* rowp = O + (size_t)(row0 + ai * HALF + m * 16) * ldc + col0;
#pragma unroll
                for (int bj = 0; bj < 2; ++bj) { const f32x4 v0 = acc[ai][bj][m][0] * sv[bj][0], v1 = acc[ai][bj][m][1] * sv[bj][1];
                    u32x4 w; w.x = cvt_pk_bf16(v0[0], v0[1]); w.y = cvt_pk_bf16(v0[2], v0[3]); w.z = cvt_pk_bf16(v1[0], v1[1]); w.w = cvt_pk_bf16(v1[2], v1[3]);
                    *(u32x4*)(rowp + bj * HALF) = w; } }
    }
};
struct EpiResid {
    static constexpr bool PERM = false, AFTER_DRAIN = false;
    const float* X; float* O; int ldc; const float* gate; int gate_bstride; int rows_per_batch;
    __device__ __forceinline__ void operator()(const f32x4 (&acc)[2][2][4][2], const Unit& u, int wr, int wc, int fr, int fq) const {
        const int row0 = u.pm * BM + wr * 64 + fr, col0 = u.pn * BM + wc * 32 + 4 * fq;
        const float* gp = gate + (size_t)((u.pm * BM) / rows_per_batch) * gate_bstride + col0;
        f32x4 gv[2][2];
#pragma unroll
        for (int bj = 0; bj < 2; ++bj)
#pragma unroll
            for (int n = 0; n < 2; ++n) gv[bj][n] = *(const f32x4*)(gp + bj * HALF + 16 * n);
#pragma unroll
        for (int ai = 0; ai < 2; ++ai)
#pragma unroll
            for (int m = 0; m < 4; ++m) { const size_t ro = (size_t)(row0 + ai * HALF + m * 16) * ldc + col0;
#pragma unroll
                for (int bj = 0; bj < 2; ++bj)
#pragma unroll
                    for (int n = 0; n < 2; ++n) { const f32x4 xv = *(const f32x4*)(X + ro + bj * HALF + 16 * n);
                        *(f32x4*)(O + ro + bj * HALF + 16 * n) = xv + gv[bj][n] * acc[ai][bj][m][n]; } }
    }
};

template <class Epi, class Sched, bool ALIGN_EPI = false, bool SP2 = false>
__device__ __forceinline__ void gemm_phase(PG8_LAS unsigned char* lds, const Gemm g, const Sched& S, const Epi& E) {
    const int tid = threadIdx.x, wid = __builtin_amdgcn_readfirstlane(tid >> 6), lane = tid & 63, wr = wid >> 2, wc = wid & 3, fr = lane & 15, fq = lane >> 4;
    const int K = g.K, nt = K / BK;
    unsigned voffA[2], voffB[2];
#pragma unroll
    for (int i = 0; i < 2; ++i) { int R, C; stage_rc(tid * 16 + i * 8192, R, C); const int Rb = Epi::PERM ? ((R & ~31) + perm32(R & 31)) : R;
        voffA[i] = (unsigned)(R * K + C) * 2u; voffB[i] = (unsigned)(Rb * K + C) * 2u; }
    const size_t kstep = (size_t)(BK * 2);
    const size_t hstep = (size_t)HALF * K * 2;
    const size_t tstep = 2 * hstep;
    const unsigned ldsw = (unsigned)wid * 1024u;
    const int aoff = lds_byte(wr * 64 + fr, fq * 8), boff = lds_byte(wc * 32 + fr, fq * 8);
#define PG8_SA(b, h) (((b) * 2 + (h)) * HTB)
#define PG8_SB(b, h) ((4 + (b) * 2 + (h)) * HTB)
#define PG8_STAGE(bufoff, gbase, voff) do { _Pragma("unroll") for (int _i = 0; _i < 2; ++_i) \
        __builtin_amdgcn_global_load_lds((const unsigned*)((const char*)(gbase) + (voff)[_i]), (PG8_LAS unsigned*)(lds + (bufoff) + ldsw + _i * 8192), 16, 0, 0); } while (0)
#define PG8_LDA(dst, b, h) do { _Pragma("unroll") for (int m = 0; m < 4; ++m) _Pragma("unroll") for (int k = 0; k < 2; ++k) dst[m][k] = *(const PG8_LAS bf16x8*)(lds + PG8_SA(b, h) + aoff + m * 2048 + k * 1024); } while (0)
#define PG8_LDB(dst, b, h) do { _Pragma("unroll") for (int n = 0; n < 2; ++n) _Pragma("unroll") for (int k = 0; k < 2; ++k) dst[n][k] = *(const PG8_LAS bf16x8*)(lds + PG8_SB(b, h) + boff + n * 2048 + k * 1024); } while (0)
#define PG8_MMA(ai, bj, At, Bt) do { __builtin_amdgcn_s_setprio(1); _Pragma("unroll") for (int m = 0; m < 4; ++m) _Pragma("unroll") for (int n = 0; n < 2; ++n) _Pragma("unroll") for (int k = 0; k < 2; ++k) \
        acc[ai][bj][m][n] = __builtin_amdgcn_mfma_f32_16x16x32_bf16(Bt[n][k], At[m][k], acc[ai][bj][m][n], 0, 0, 0); __builtin_amdgcn_s_setprio(0); } while (0)
#define PG8_WAIT_V(n) asm volatile("s_waitcnt vmcnt(" #n ")" ::: "memory")
#define PG8_WAIT_L(n) asm volatile("s_waitcnt lgkmcnt(" #n ")" ::: "memory")
#define PG8_BAR __builtin_amdgcn_s_barrier()
#define PG8_SCHED __builtin_amdgcn_sched_barrier(0)
    Unit cur, nxt; int ui = 0;
    if (!S.next(0, cur)) return;
    f32x4 acc[2][2][4][2];
#pragma unroll
    for (int a = 0; a < 2; ++a)
#pragma unroll
        for (int b = 0; b < 2; ++b)
#pragma unroll
            for (int m = 0; m < 4; ++m)
#pragma unroll
                for (int n = 0; n < 2; ++n) acc[a][b][m][n] = (f32x4){0.f, 0.f, 0.f, 0.f};
    bf16x8 At[4][2], B0[2][2], B1[2][2];
    const char* cA = (const char*)g.A + (size_t)cur.pm * tstep + (size_t)(cur.pn / g.png) * g.agb; const char* cB = (const char*)g.Bt + (size_t)cur.pn * tstep;
    S.a_ready(cur);
    if constexpr (SP2) {
        PG8_STAGE(PG8_SB(0, 0), cB, voffB); PG8_STAGE(PG8_SB(0, 1), cB + hstep, voffB); PG8_STAGE(PG8_SA(0, 0), cA, voffA); PG8_STAGE(PG8_SA(0, 1), cA + hstep, voffA);
        if (wr == 1) PG8_BAR;
        PG8_WAIT_V(2); PG8_BAR;
        PG8_STAGE(PG8_SB(1, 0), cB + kstep, voffB); PG8_STAGE(PG8_SA(1, 0), cA + kstep, voffA); PG8_STAGE(PG8_SB(1, 1), cB + hstep + kstep, voffB);
        PG8_WAIT_V(6); PG8_BAR;
    } else {
        PG8_STAGE(PG8_SB(0, 0), cB, voffB); PG8_STAGE(PG8_SA(0, 0), cA, voffA); PG8_STAGE(PG8_SB(0, 1), cB + hstep, voffB); PG8_STAGE(PG8_SA(0, 1), cA + hstep, voffA);
        if (wr == 1) PG8_BAR;
        PG8_WAIT_V(4); PG8_BAR;
        PG8_STAGE(PG8_SB(1, 0), cB + kstep, voffB); PG8_STAGE(PG8_SA(1, 0), cA + kstep, voffA); PG8_STAGE(PG8_SB(1, 1), cB + hstep + kstep, voffB);
        PG8_WAIT_V(6); PG8_BAR;
    }
    for (;;) {
        const bool has_next = S.next(ui + 1, nxt);
        const char* nA = has_next ? (const char*)g.A + (size_t)nxt.pm * tstep + (size_t)(nxt.pn / g.png) * g.agb : cA; const char* nB = has_next ? (const char*)g.Bt + (size_t)nxt.pn * tstep : cB;
        for (int t = 0; t < nt; t += 2) {
            const bool last = (t == nt - 2);
            const char* a1 = cA + (size_t)(t + 1) * kstep;
            const char* a2 = last ? nA : cA + (size_t)(t + 2) * kstep; const char* b2 = last ? nB : cB + (size_t)(t + 2) * kstep;
            const char* a3 = a2 + kstep; const char* b3 = b2 + kstep;
            if (last && has_next) S.a_ready(nxt);
            if constexpr (SP2) {
            PG8_LDB(B0, 0, 0); PG8_LDB(B1, 0, 1); PG8_SCHED; PG8_LDA(At, 0, 0); PG8_STAGE(PG8_SA(1, 1), a1 + hstep, voffA);
            PG8_WAIT_V(8); PG8_WAIT_L(0); PG8_BAR; PG8_MMA(0, 0, At, B0); PG8_MMA(0, 1, At, B1); PG8_BAR; PG8_SCHED;
            PG8_LDA(At, 0, 1); PG8_STAGE(PG8_SB(0, 0), b2, voffB); PG8_STAGE(PG8_SB(0, 1), b2 + hstep, voffB); PG8_STAGE(PG8_SA(0, 0), a2, voffA);
            PG8_WAIT_V(8); PG8_WAIT_L(0); PG8_BAR; PG8_MMA(1, 0, At, B0); PG8_MMA(1, 1, At, B1); PG8_BAR; PG8_SCHED;
            PG8_LDB(B0, 1, 0); PG8_LDB(B1, 1, 1); PG8_SCHED; PG8_LDA(At, 1, 0); PG8_STAGE(PG8_SA(0, 1), a2 + hstep, voffA);
            PG8_WAIT_V(8); PG8_WAIT_L(0); PG8_BAR; PG8_MMA(0, 0, At, B0); PG8_MMA(0, 1, At, B1); PG8_BAR; PG8_SCHED;
            PG8_LDA(At, 1, 1); PG8_STAGE(PG8_SB(1, 0), b3, voffB); PG8_STAGE(PG8_SB(1, 1), b3 + hstep, voffB); PG8_STAGE(PG8_SA(1, 0), a3, voffA);
            PG8_WAIT_V(8); PG8_WAIT_L(0); PG8_BAR; PG8_MMA(1, 0, At, B0); PG8_MMA(1, 1, At, B1); PG8_BAR; PG8_SCHED;
            } else {
            PG8_LDB(B0, 0, 0); PG8_SCHED; PG8_LDA(At, 0, 0); PG8_STAGE(PG8_SA(1, 1), a1 + hstep, voffA);
            PG8_WAIT_L(8); PG8_BAR; PG8_WAIT_L(0); PG8_MMA(0, 0, At, B0); PG8_BAR; PG8_SCHED;
            PG8_LDB(B1, 0, 1); PG8_STAGE(PG8_SB(0, 0), b2, voffB);
            PG8_BAR; PG8_WAIT_L(0); PG8_MMA(0, 1, At, B1); PG8_BAR;
            PG8_LDA(At, 0, 1); PG8_STAGE(PG8_SA(0, 0), a2, voffA);
            PG8_BAR; PG8_WAIT_L(0); PG8_MMA(1, 0, At, B0); PG8_BAR; PG8_SCHED;
            PG8_STAGE(PG8_SB(0, 1), b2 + hstep, voffB);
            PG8_WAIT_V(6); PG8_BAR; PG8_MMA(1, 1, At, B1); PG8_BAR;
            PG8_LDB(B0, 1, 0); PG8_SCHED; PG8_LDA(At, 1, 0); PG8_STAGE(PG8_SA(0, 1), a2 + hstep, voffA);
            PG8_WAIT_L(8); PG8_BAR; PG8_WAIT_L(0); PG8_MMA(0, 0, At, B0); PG8_BAR; PG8_SCHED;
            PG8_LDB(B1, 1, 1); PG8_STAGE(PG8_SB(1, 0), b3, voffB);
            PG8_BAR; PG8_WAIT_L(0); PG8_MMA(0, 1, At, B1); PG8_BAR;
            PG8_LDA(At, 1, 1); PG8_STAGE(PG8_SA(1, 0), a3, voffA);
            PG8_BAR; PG8_WAIT_L(0); PG8_MMA(1, 0, At, B0); PG8_BAR; PG8_SCHED;
            PG8_STAGE(PG8_SB(1, 1), b3 + hstep, voffB);
            PG8_WAIT_V(6); PG8_BAR; PG8_MMA(1, 1, At, B1); PG8_BAR;
            }
        }
        if constexpr (ALIGN_EPI) { if (wr == 0) PG8_BAR; }
        if constexpr (!Epi::AFTER_DRAIN) { E(acc, cur, wr, wc, fr, fq); S.done(cur); }
        if (!has_next) break;
#pragma unroll
        for (int a = 0; a < 2; ++a)
#pragma unroll
            for (int b = 0; b < 2; ++b)
#pragma unroll
                for (int m = 0; m < 4; ++m)
#pragma unroll
                    for (int n = 0; n < 2; ++n) acc[a][b][m][n] = (f32x4){0.f, 0.f, 0.f, 0.f};
        cur = nxt; cA = nA; cB = nB; ++ui;
        if constexpr (ALIGN_EPI) { if (wr == 1) PG8_BAR; }
    }
    PG8_WAIT_V(0);
    if constexpr (!ALIGN_EPI) { if (wr == 0) PG8_BAR; }
    PG8_BAR;
    if constexpr (Epi::AFTER_DRAIN) { E.fused(acc, cur, wr, wc, fr, fq, lds, wid, lane); S.done(cur); }
#undef PG8_SA
#undef PG8_SB
#undef PG8_STAGE
#undef PG8_LDA
#undef PG8_LDB
#undef PG8_MMA
#undef PG8_WAIT_V
#undef PG8_WAIT_L
#undef PG8_BAR
#undef PG8_SCHED
}
}
constexpr int NWAVES = 8;
constexpr int BATCH = 4, SEQ = 4096, D = 4096, M = BATCH * SEQ;
constexpr int DATTN = 2048, DPOOL = 2048, HD = 128, NH = 16, NPROJ = 3 * DATTN + DPOOL;
constexpr int NGRP = 4, PGRP = 512;
constexpr int MODW = 6 * D;
constexpr int PH = 8, PK = 16, NKEYS = 128, PDQ = 256, PDH = 128, NQ = PH * PDQ;
constexpr float EPS = 1e-6f;
constexpr int NPHASE = 10;
#ifndef MK_N_LAUNCHES
#define MK_N_LAUNCHES 10
#endif
constexpr int N_LAUNCHES = MK_N_LAUNCHES;

constexpr size_t MiB = 1u << 20;
constexpr size_t WS_CTL = 0, CTL_ZERO_BYTES = 1 * MiB;
constexpr size_t WS_MOD = 1 * MiB;
constexpr size_t WS_SK = 2 * MiB;
constexpr size_t WS_WPT = 3 * MiB;
constexpr size_t WS_IDX = 8 * MiB, WS_GW = 16 * MiB;
constexpr size_t WS_WQT = 32 * MiB, WS_WOUTT = 64 * MiB, WS_WINT = 96 * MiB;
constexpr size_t WS_H = 160 * MiB;
constexpr size_t WS_PROJ = 288 * MiB;
constexpr size_t WS_CAT = 544 * MiB;
constexpr size_t WS_DP = 672 * MiB;
constexpr size_t WS_QP = 736 * MiB;
constexpr size_t WS_X1 = 800 * MiB;
constexpr size_t WS_END = 1056 * MiB;
constexpr int CW_TMO = 0, CW_CODE = 1, CW_BAR = 4096;
constexpr int RING_OFF = 0, RING_BYTES = 131072;
constexpr int LDSCTL_OFF = RING_BYTES, MISC_OFF = LDSCTL_OFF + 320;
constexpr int LDS_BYTES = 147456;
static_assert(MISC_OFF + 128 <= LDS_BYTES, "LDS map");
#define GAS __attribute__((address_space(1)))
#define LAS __attribute__((address_space(3)))
typedef unsigned short bf16;
typedef unsigned v4u __attribute__((ext_vector_type(4)));
typedef float f32x4 __attribute__((ext_vector_type(4)));
typedef short bf16x8 __attribute__((ext_vector_type(8)));
typedef GAS unsigned gu32;
typedef GAS unsigned long long gu64;
#define RLX_AGENT __ATOMIC_RELAXED, __HIP_MEMORY_SCOPE_AGENT
#define LDS_WAIT() asm volatile("s_waitcnt lgkmcnt(0)" ::: "memory")
#define VM_WAIT() asm volatile("s_waitcnt vmcnt(0)" ::: "memory")
__device__ __forceinline__ unsigned long long rt() { return __builtin_amdgcn_s_memrealtime(); }
__device__ __forceinline__ unsigned f2bf(float f) { unsigned u = __builtin_bit_cast(unsigned, f); return (u + 0x7fffu + ((u >> 16) & 1u)) >> 16; }
__device__ __forceinline__ unsigned pk2(float lo, float hi) { return f2bf(lo) | (f2bf(hi) << 16); }

#define XB_TMO      128
#define XB_XCNT(j)  (256  + 64 * (j))
#define XB_XSUB(j)  (1280 + 64 * (j))
#define XB_XGEN(j)  (2304 + 64 * (j))
#define XB_TOP      3328
#define XB_TOPGEN   3392
#define XCD_BAR_WORDS 3456
#define XB_SPIN_CAP (1u << 18)

__device__ __forceinline__ unsigned xb_ld(unsigned* p)              { return __hip_atomic_load(p, __ATOMIC_RELAXED, __HIP_MEMORY_SCOPE_AGENT); }
__device__ __forceinline__ unsigned xb_add(unsigned* p, unsigned v) { return __hip_atomic_fetch_add(p, v, __ATOMIC_RELAXED, __HIP_MEMORY_SCOPE_AGENT); }
__device__ __forceinline__ unsigned xb_xcc_id() { return (unsigned)__builtin_amdgcn_s_getreg((3 << 11) | 20) & 0xFu; }
#define XB_SPIN(cond, bar) do { unsigned _sp = 0; while (cond) { __builtin_amdgcn_s_sleep(1); \
    if ((++_sp & 255u) == 0u) { if (xb_ld(&(bar)[XB_TMO])) break; if (_sp > XB_SPIN_CAP) { atomicAdd(&(bar)[XB_TMO], 1u); break; } } } } while (0)

struct XcdBarrier {
    unsigned* bar; unsigned x;
    volatile LAS unsigned* st;
};

__device__ __forceinline__ XcdBarrier xcd_barrier_post(unsigned* bar, volatile LAS unsigned* st) {
    XcdBarrier b; b.bar = bar; b.x = xb_xcc_id(); b.st = st;
    if (threadIdx.x == 0) (void)xb_add(&bar[XB_XCNT(b.x)], 1u);
    return b;
}
__device__ __forceinline__ void xcd_barrier_complete(unsigned* bar, unsigned x, unsigned& nloc, unsigned& nx) {
    const unsigned G = gridDim.x * gridDim.y * gridDim.z;
    unsigned sum, cnt, mine, sp = 0u;
    for (;;) {
        sum = 0u; cnt = 0u; mine = 0u;
#pragma unroll
        for (unsigned j = 0; j < 16; ++j) { const unsigned c = xb_ld(&bar[XB_XCNT(j)]); sum += c; cnt += (c > 0u) ? 1u : 0u; mine = (j == x) ? c : mine; }
        if (sum == G) break;
        __builtin_amdgcn_s_sleep(1);
        if ((++sp & 255u) == 0u) { if (xb_ld(&bar[XB_TMO])) break; if (sp > XB_SPIN_CAP) { atomicAdd(&bar[XB_TMO], 1u); break; } }
    }
    nloc = mine > 0u ? mine : 1u; nx = cnt > 0u ? cnt : 1u;
}

__device__ __forceinline__ void xcd_barrier(const XcdBarrier& b) {
    asm volatile("s_waitcnt vmcnt(0)" ::: "memory");
    __syncthreads();
    if (threadIdx.x == 0) {
        unsigned* bar = b.bar;
        __builtin_amdgcn_s_waitcnt(0);
        unsigned nloc = b.st[0], nx = b.st[1];
        if (nloc == 0u) { xcd_barrier_complete(bar, b.x, nloc, nx); b.st[0] = nloc; b.st[1] = nx; }
        const unsigned old = xb_add(&bar[XB_XSUB(b.x)], 1u);
        const unsigned gen = old / nloc;
        if (old + 1u == (gen + 1u) * nloc) {
            __builtin_amdgcn_fence(__ATOMIC_RELEASE, "agent");
            asm volatile("s_waitcnt vmcnt(0)" ::: "memory");
            const unsigned og = xb_add(&bar[XB_TOP], 1u);
            const unsigned tg = og / nx;
            if (og + 1u == (tg + 1u) * nx) xb_add(&bar[XB_TOPGEN], 1u);
            else XB_SPIN(xb_ld(&bar[XB_TOPGEN]) == tg, bar);
            __builtin_amdgcn_fence(__ATOMIC_ACQUIRE, "agent");
            xb_add(&bar[XB_XGEN(b.x)], 1u);
            asm volatile("s_waitcnt vmcnt(0)" ::: "memory");
        } else {
            XB_SPIN(xb_ld(&bar[XB_XGEN(b.x)]) == gen, bar);
            __builtin_amdgcn_fence(__ATOMIC_ACQUIRE, "agent");
            asm volatile("s_waitcnt vmcnt(0)" ::: "memory");
        }
    }
    __syncthreads();
}
typedef float f32x16 __attribute__((ext_vector_type(16)));
typedef short s16x4 __attribute__((ext_vector_type(4)));
typedef __bf16 bf16v2 __attribute__((ext_vector_type(2)));
#define DI __device__ __forceinline__
#define MFMA32(a, b, c) __builtin_amdgcn_mfma_f32_32x32x16_bf16((a), (b), (c), 0, 0, 0)
DI unsigned pkbf(float lo, float hi) { bf16v2 v = {(__bf16)lo, (__bf16)hi}; return __builtin_bit_cast(unsigned, v); }
DI float bflo(unsigned u) { return __builtin_bit_cast(float, u << 16); }
DI float bfhi(unsigned u) { return __builtin_bit_cast(float, u & 0xffff0000u); }
DI int crow(int reg, int h) { return (reg & 3) + 8 * (reg >> 2) + 4 * h; }
DI float wave_sum(float v) {
#pragma unroll
    for (int o = 1; o < 64; o <<= 1) v += __shfl_xor(v, o);
    return v;
}
struct Frame {
    LAS unsigned char* lds;
    volatile LAS unsigned* MISC;
    gu32* ctl;
    int tid, lane, wave, vcu, G;
    const float *x, *c, *w_ada, *b_ada, *g1, *w_in, *g_ah, *w_pool, *s_pool, *w_out, *g2, *w_query, *sk1, *sk2, *u_exp, *v_exp, *g_final;
    float* out;
    float* MOD; bf16 *SK, *WPT, *WQT, *WOUTT, *WINT, *H, *PROJ, *CAT, *DP, *QP; float* X1; int* IDX; float* GW;
};

DI void p0_transpose_item(const float* W, int K, int N, bf16* WT, int row_off, LAS float* scr, int item, int lane) {
    const int nblk = N / 32, kb = item / nblk, nb = item % nblk, k0 = 64 * kb, n0 = 32 * nb;
#pragma unroll 8
    for (int i = 0; i < 32; ++i) { const int kk = 2 * i + (lane >> 5); scr[kk * 33 + (lane & 31)] = W[(size_t)(k0 + kk) * N + n0 + (lane & 31)]; }
    LDS_WAIT(); asm volatile("" ::: "memory");
    const int c = lane & 7;
#pragma unroll
    for (int j = 0; j < 4; ++j) { const int n = (lane >> 3) + 8 * j; const LAS float* s = scr + (8 * c) * 33 + n;
        v4u o; o.x = pkbf(s[0 * 33], s[1 * 33]); o.y = pkbf(s[2 * 33], s[3 * 33]); o.z = pkbf(s[4 * 33], s[5 * 33]); o.w = pkbf(s[6 * 33], s[7 * 33]);
        *(GAS v4u*)(WT + (size_t)(row_off + n0 + n) * K + k0 + 8 * c) = o; }
    LDS_WAIT(); asm volatile("" ::: "memory");
}
DI void ph0_prologue(Frame& F) {
    LAS float* sc = (LAS float*)(F.lds + RING_OFF);
    LAS float* red = (LAS float*)(F.lds + RING_OFF + 65536);
    for (int i = F.tid; i < BATCH * D; i += NWAVES * 64) { const float cv = F.c[i]; sc[i] = cv / (1.f + __expf(-cv)); }
    __syncthreads();
    const int cq = F.tid % 24, rl = F.tid / 24;
    for (int cc = F.vcu; cc < MODW / 96; cc += F.G) {
        if (rl < 21) {
            f32x4 a0 = {0.f, 0.f, 0.f, 0.f}, a1 = a0, a2 = a0, a3 = a0;
            const float* wp = F.w_ada + (size_t)rl * MODW + 96 * cc + 4 * cq;
#pragma unroll 4
            for (int d = rl; d < D; d += 21) { const f32x4 w = *(const GAS f32x4*)wp; wp += (size_t)21 * MODW;
                a0 += sc[d] * w; a1 += sc[D + d] * w; a2 += sc[2 * D + d] * w; a3 += sc[3 * D + d] * w; }
            LAS f32x4* rp = (LAS f32x4*)(red + (rl * 24 + cq) * 16); rp[0] = a0; rp[1] = a1; rp[2] = a2; rp[3] = a3;
        }
        __syncthreads();
        if (F.tid < 384) { const int q = F.tid >> 4, e = F.tid & 15; float s = 0.f;
            for (int r2 = 0; r2 < 21; ++r2) s += red[(r2 * 24 + q) * 16 + e];
            const int col = 96 * cc + 4 * q + (e & 3); F.MOD[(e >> 2) * MODW + col] = s + F.b_ada[col]; }
        __syncthreads();
    }
    LAS float* scr = (LAS float*)(F.lds + RING_OFF + F.wave * 16384);
    const int gw = F.vcu * NWAVES + F.wave, NGW = F.G * NWAVES;
    constexpr int I_IN = (D / 64) * (NPROJ / 32), I_OUT = (D / 64) * (D / 32), I_Q = (D / 64) * (NQ / 32), I_P1 = (PGRP / 64) * (PGRP / 32);
    constexpr int NITEMS = I_IN + I_OUT + I_Q + NGRP * I_P1;
    for (int it = gw; it < NITEMS; it += NGW) {
        int r = it;
        if (r < I_IN) { p0_transpose_item(F.w_in, D, NPROJ, F.WINT, 0, scr, r, F.lane); continue; } r -= I_IN;
        if (r < I_OUT) { p0_transpose_item(F.w_out, D, D, F.WOUTT, 0, scr, r, F.lane); continue; } r -= I_OUT;
        if (r < I_Q) { p0_transpose_item(F.w_query, D, NQ, F.WQT, 0, scr, r, F.lane); continue; } r -= I_Q;
        const int g = r / I_P1; r -= g * I_P1;
        p0_transpose_item(F.w_pool + (size_t)g * PGRP * PGRP, PGRP, PGRP, F.WPT, g * PGRP, scr, r, F.lane);
    }
    for (int i = F.vcu * NWAVES * 64 + F.tid; i < NKEYS * PDH; i += F.G * NWAVES * 64) {
        const float* src = (i < NKEYS * PDH / 2) ? F.sk1 + 2 * i : F.sk2 + 2 * (i - NKEYS * PDH / 2);
        ((GAS unsigned*)F.SK)[i] = pkbf(src[0], src[1]);
    }
}

DI void norm_phase(Frame& F, const float* src, const float* gain, int kshift, int kscale, bf16* dst) {
    LAS float* A1 = (LAS float*)(F.lds + RING_OFF);
    LAS float* S1 = A1 + D;
    for (int rt = F.vcu; rt < M / 64; rt += F.G) {
        const int b = (rt * 64) / SEQ;
        __syncthreads();
        for (int i = F.tid; i < D; i += NWAVES * 64) { A1[i] = gain[i] * (1.f + F.MOD[b * MODW + kscale * D + i]); S1[i] = F.MOD[b * MODW + kshift * D + i]; }
        __syncthreads();
        for (int i = 0; i < 8; ++i) {
            const int m = rt * 64 + F.wave * 8 + i;
            const GAS f32x4* xr = (const GAS f32x4*)(src + (size_t)m * D) + F.lane;
            f32x4 v[16]; float ss = 0.f;
#pragma unroll
            for (int j = 0; j < 16; ++j) { v[j] = xr[64 * j]; ss += (v[j].x * v[j].x + v[j].y * v[j].y) + (v[j].z * v[j].z + v[j].w * v[j].w); }
            const float rstd = 1.f / sqrtf(wave_sum(ss) * (1.f / D) + EPS);
            GAS unsigned long long* o8 = (GAS unsigned long long*)(dst + (size_t)m * D) + F.lane;
#pragma unroll
            for (int j = 0; j < 16; ++j) { const f32x4 a = *(const LAS f32x4*)(A1 + 4 * F.lane + 256 * j), s = *(const LAS f32x4*)(S1 + 4 * F.lane + 256 * j);
                const f32x4 o = v[j] * rstd * a + s;
                o8[64 * j] = (unsigned long long)pkbf(o.x, o.y) | ((unsigned long long)pkbf(o.z, o.w) << 32); }
        }
    }
}

DI void pool_diff_phase(Frame& F) {
    const int gt = F.vcu * NWAVES * 64 + F.tid, NT = F.G * NWAVES * 64;
    for (int it = gt; it < M * (DPOOL / 8); it += NT) {
        const int m = it >> 8, ci = it & 255, c0 = ci * 8, g = c0 >> 9, w = 2 << g, pos = m & (SEQ - 1);
        const int cnt = (pos + 1 < w) ? pos + 1 : w;
        const bf16* p = F.PROJ + (size_t)m * NPROJ + 3 * DATTN + c0;
        const v4u cur = *(const GAS v4u*)p;
        float s0 = 0.f, s1 = 0.f, s2 = 0.f, s3 = 0.f, s4 = 0.f, s5 = 0.f, s6 = 0.f, s7 = 0.f;
        for (int i = 0; i < cnt; ++i) { const v4u v = *(const GAS v4u*)(p - (size_t)i * NPROJ);
            s0 += bflo(v.x); s1 += bfhi(v.x); s2 += bflo(v.y); s3 += bfhi(v.y); s4 += bflo(v.z); s5 += bfhi(v.z); s6 += bflo(v.w); s7 += bfhi(v.w); }
        const float inv = 1.f / (float)cnt;
        v4u o; o.x = pkbf(s0 * inv - bflo(cur.x), s1 * inv - bfhi(cur.x)); o.y = pkbf(s2 * inv - bflo(cur.y), s3 * inv - bfhi(cur.y));
        o.z = pkbf(s4 * inv - bflo(cur.z), s5 * inv - bfhi(cur.z)); o.w = pkbf(s6 * inv - bflo(cur.w), s7 * inv - bfhi(cur.w));
        *(GAS v4u*)(F.DP + ((size_t)g * M + m) * PGRP + (c0 - g * PGRP)) = o;
    }
}

constexpr int VP = 288;
DI void attn_task(Frame& F, LAS unsigned char* wl, int bh, int qt) {
    const int lane = F.lane, r = lane & 31, hh = lane >> 5;
    const int b = bh >> 4, h = bh & 15, t0 = 32 * qt;
    const bf16* base = F.PROJ + (size_t)b * SEQ * NPROJ + h * HD;
    bf16x8 qf[8];
    { const bf16* qp = base + (size_t)(t0 + r) * NPROJ + 8 * hh;
#pragma unroll
      for (int ks = 0; ks < 8; ++ks) qf[ks] = *(const GAS bf16x8*)(qp + 16 * ks); }
    f32x16 o[4];
#pragma unroll
    for (int c = 0; c < 4; ++c)
#pragma unroll
        for (int i = 0; i < 16; ++i) o[c][i] = 0.f;
    float R = 0.f;
    const float SC = 0.08838834764831845f * 1.4426950408889634f;
    const int tq = t0 + r;
    const int L16 = lane & 15, trq = L16 >> 2, trp = L16 & 3, blk = (lane >> 4) & 1;
    const unsigned traddr0 = (unsigned)((4 * hh + trq) * VP + (16 * blk + 4 * trp) * 2);
    for (int kb = qt; kb >= 0; --kb) {
        const int s0 = 32 * kb;
        bf16x8 kf[8];
        { const bf16* kp = base + (size_t)(s0 + r) * NPROJ + DATTN + 8 * hh;
#pragma unroll
          for (int ks = 0; ks < 8; ++ks) kf[ks] = *(const GAS bf16x8*)(kp + 16 * ks); }
        v4u vv[8];
#pragma unroll
        for (int li = 0; li < 8; ++li) { const int ch = li * 64 + lane, key = ch >> 4, dc = ch & 15;
            vv[li] = *(const GAS v4u*)(base + (size_t)(s0 + key) * NPROJ + 2 * DATTN + 8 * dc); }
        f32x16 s;
#pragma unroll
        for (int i = 0; i < 16; ++i) s[i] = 0.f;
#pragma unroll
        for (int ks = 0; ks < 8; ++ks) s = MFMA32(kf[ks], qf[ks], s);
#pragma unroll
        for (int li = 0; li < 8; ++li) { const int ch = li * 64 + lane, key = ch >> 4, dc = ch & 15;
            *(LAS v4u*)(wl + key * VP + dc * 16) = vv[li]; }
        const bool diag = (kb == qt);
        float zz[16], sp[16], ln[16];
#pragma unroll
        for (int i = 0; i < 16; ++i) {
            zz[i] = s[i] * SC;
            const float e = __builtin_amdgcn_exp2f(-__builtin_fabsf(zz[i]));
            sp[i] = fmaxf(zz[i], 0.f) + __builtin_amdgcn_logf(1.f + e);
            const bool valid = !diag || (s0 + crow(i, hh) < tq);
            ln[i] = valid ? -sp[i] : 0.f;
        }
        float Gs[4], Ps[4];
#pragma unroll
        for (int g = 0; g < 4; ++g) Gs[g] = (ln[4 * g] + ln[4 * g + 1]) + (ln[4 * g + 2] + ln[4 * g + 3]);
#pragma unroll
        for (int g = 0; g < 4; ++g) Ps[g] = __shfl_xor(Gs[g], 32);
        float later[4];
        later[3] = 0.f; later[2] = Gs[3] + Ps[3]; later[1] = later[2] + (Gs[2] + Ps[2]); later[0] = later[1] + (Gs[1] + Ps[1]);
        const float T = later[0] + (Gs[0] + Ps[0]);
        float a[16];
#pragma unroll
        for (int g = 0; g < 4; ++g) {
            const float bg = R + later[g] + ((hh == 0) ? Ps[g] : 0.f);
            const float w2 = ln[4 * g + 3], w1 = w2 + ln[4 * g + 2], w0 = w1 + ln[4 * g + 1];
            const float wv[4] = {w0, w1, w2, 0.f};
#pragma unroll
            for (int rr = 0; rr < 4; ++rr) { const int i = 4 * g + rr;
                const bool valid = !diag || (s0 + crow(i, hh) < tq);
                const float ex = __builtin_amdgcn_exp2f((zz[i] - sp[i]) + (bg + wv[rr]));
                a[i] = valid ? ex : 0.f; }
        }
        R += T;
        v4u x0, x1;
        x0.x = pkbf(a[0], a[1]); x0.y = pkbf(a[2], a[3]); x0.z = pkbf(a[4], a[5]); x0.w = pkbf(a[6], a[7]);
        x1.x = pkbf(a[8], a[9]); x1.y = pkbf(a[10], a[11]); x1.z = pkbf(a[12], a[13]); x1.w = pkbf(a[14], a[15]);
        const bf16x8 xs0 = __builtin_bit_cast(bf16x8, x0), xs1 = __builtin_bit_cast(bf16x8, x1);
#pragma unroll
        for (int c = 0; c < 4; ++c) {
            const s16x4 l0 = __builtin_amdgcn_ds_read_tr16_b64_v4i16((LAS s16x4*)(wl + traddr0 + 64 * c));
            const s16x4 h0 = __builtin_amdgcn_ds_read_tr16_b64_v4i16((LAS s16x4*)(wl + traddr0 + 8 * VP + 64 * c));
            const s16x4 l1 = __builtin_amdgcn_ds_read_tr16_b64_v4i16((LAS s16x4*)(wl + traddr0 + 16 * VP + 64 * c));
            const s16x4 h1 = __builtin_amdgcn_ds_read_tr16_b64_v4i16((LAS s16x4*)(wl + traddr0 + 24 * VP + 64 * c));
            const bf16x8 vf0 = __builtin_shufflevector(l0, h0, 0, 1, 2, 3, 4, 5, 6, 7), vf1 = __builtin_shufflevector(l1, h1, 0, 1, 2, 3, 4, 5, 6, 7);
            o[c] = MFMA32(vf0, xs0, o[c]);
            o[c] = MFMA32(vf1, xs1, o[c]);
        }
        if (__all(R < -160.f)) break;
    }
    float ss = 0.f;
#pragma unroll
    for (int c = 0; c < 4; ++c)
#pragma unroll
        for (int i = 0; i < 16; ++i) ss += o[c][i] * o[c][i];
    ss += __shfl_xor(ss, 32);
    const float rstd = 1.f / sqrtf(ss * (1.f / HD) + EPS);
    bf16* orow = F.CAT + (size_t)(b * SEQ + t0 + r) * D + h * HD;
    const float* gp = F.g_ah + h * HD;
#pragma unroll
    for (int c = 0; c < 4; ++c)
#pragma unroll
        for (int g = 0; g < 4; ++g) { const int d0 = 32 * c + 8 * g + 4 * hh; const f32x4 gv = *(const GAS f32x4*)(gp + d0);
            const unsigned lo = pkbf(o[c][4 * g] * rstd * gv.x, o[c][4 * g + 1] * rstd * gv.y), hi = pkbf(o[c][4 * g + 2] * rstd * gv.z, o[c][4 * g + 3] * rstd * gv.w);
            *(GAS unsigned long long*)(orow + d0) = (unsigned long long)lo | ((unsigned long long)hi << 32); }
}
DI void attn_phase(Frame& F) {
    LAS unsigned char* wl = F.lds + RING_OFF + F.wave * 16384;
    const int gw = F.vcu * NWAVES + F.wave, NGW = F.G * NWAVES;
    for (int wt = gw; wt < BATCH * NH * (SEQ / 32); wt += NGW) attn_task(F, wl, wt >> 7, wt & 127);
}
DI int f2key(float f) { const int b = __builtin_bit_cast(int, f); return b ^ ((b >> 31) & 0x7fffffff); }
DI float key2f(int k) { const int b = k ^ ((k >> 31) & 0x7fffffff); return __builtin_bit_cast(float, b); }
DI void ce_desc(int& a, int& b) { const int hi = a > b ? a : b, lo = a > b ? b : a; a = hi; b = lo; }
DI int imax(int a, int b) { return a > b ? a : b; }
DI void sort16_desc(int (&v)[16]) {
#pragma unroll
    for (int k = 2; k <= 16; k <<= 1)
#pragma unroll
        for (int j = k >> 1; j > 0; j >>= 1)
#pragma unroll
            for (int i = 0; i < 16; ++i) { const int l = i ^ j; if (l > i) { if ((i & k) == 0) ce_desc(v[i], v[l]); else ce_desc(v[l], v[i]); } }
}
DI void bitonic_merge16_desc(int (&v)[16]) {
#pragma unroll
    for (int j = 8; j > 0; j >>= 1)
#pragma unroll
        for (int i = 0; i < 16; ++i) { const int l = i ^ j; if (l > i) ce_desc(v[i], v[l]); }
}
DI void merge_top16(int (&A)[16], const int (&B)[16]) {
#pragma unroll
    for (int i = 0; i < 16; ++i) A[i] = imax(A[i], B[15 - i]);
    bitonic_merge16_desc(A);
}
DI void route_scores(Frame& F, int tok, int hd, int half, int r, int hh, int (&tk)[16]) {
    bf16x8 qf[8];
    { const bf16* qp = F.QP + (size_t)tok * NQ + hd * PDQ + half * PDH + 8 * hh;
#pragma unroll
      for (int ks = 0; ks < 8; ++ks) qf[ks] = *(const GAS bf16x8*)(qp + 16 * ks); }
    int top[16];
#pragma unroll
    for (int c = 0; c < 4; ++c) {
        f32x16 s;
#pragma unroll
        for (int i = 0; i < 16; ++i) s[i] = 0.f;
        const bf16* kp = F.SK + (size_t)half * NKEYS * PDH + (size_t)(32 * c + r) * PDH + 8 * hh;
#pragma unroll
        for (int ks = 0; ks < 8; ++ks) { const bf16x8 kf = *(const GAS bf16x8*)(kp + 16 * ks); s = MFMA32(kf, qf[ks], s); }
        int kk[16];
#pragma unroll
        for (int i = 0; i < 16; ++i) kk[i] = (f2key(s[i]) & ~127) | (32 * c + (i & 3) + 8 * (i >> 2) + 4 * hh);
        sort16_desc(kk);
        if (c == 0) {
#pragma unroll
            for (int i = 0; i < 16; ++i) top[i] = kk[i];
        } else merge_top16(top, kk);
        __builtin_amdgcn_sched_barrier(0);
    }
    int pk[16];
#pragma unroll
    for (int i = 0; i < 16; ++i) pk[i] = __shfl_xor(top[i], 32);
    merge_top16(top, pk);
#pragma unroll
    for (int i = 0; i < 16; ++i) tk[i] = top[i];
}
struct CandTab { int a[50], b[50]; };
DI void route_task(Frame& F, LAS unsigned* wl, int tt, int hd) {
    const int lane = F.lane, r = lane & 31, hh = lane >> 5;
    const int tok = 32 * tt + r;
    int t1[16], t2[16];
    route_scores(F, tok, hd, 0, r, hh, t1);
    route_scores(F, tok, hd, 1, r, hh, t2);
    float v1[16], v2[16];
#pragma unroll
    for (int k = 0; k < 16; ++k) { wl[k * 64 + lane] = (unsigned)(t1[k] & 127); wl[(16 + k) * 64 + lane] = (unsigned)(t2[k] & 127);
        v1[k] = key2f(t1[k] & ~127); v2[k] = key2f(t2[k] & ~127); }
    int top[16];
#pragma unroll
    for (int bb = 0; bb < 16; ++bb) top[bb] = (f2key(v1[0] + v2[bb]) & ~255) | (15 - bb);
#pragma unroll
    for (int a = 1; a < 8; ++a) {
        int row[16];
#pragma unroll
        for (int bb = 0; bb < 16; ++bb) row[bb] = ((a + 1) * (bb + 1) <= 16) ? ((f2key(v1[a] + v2[bb]) & ~255) | (a << 4) | (15 - bb)) : (int)0x80000000;
        merge_top16(top, row);
    }
    { int row[16];
#pragma unroll
      for (int q = 0; q < 16; ++q) row[q] = (q < 8) ? ((f2key(v1[8 + q] + v2[0]) & ~255) | ((8 + q) << 4) | 15) : (int)0x80000000;
      merge_top16(top, row); }
    float fv[16]; int fe[16];
#pragma unroll
    for (int k = 0; k < 16; ++k) { const int a = (top[k] >> 4) & 15, bb = 15 - (top[k] & 15);
        fe[k] = (int)(wl[a * 64 + lane] * NKEYS + wl[(16 + bb) * 64 + lane]); fv[k] = key2f(top[k] & ~255); }
    float ev[16], sum = 0.f;
#pragma unroll
    for (int k = 0; k < 16; ++k) { ev[k] = __expf(fv[k] - fv[0]); sum += ev[k]; }
    const float inv = 1.f / sum;
    if (hh == 0) {
        GAS v4u* ip = (GAS v4u*)(F.IDX + (size_t)tok * (PH * PK) + hd * PK); GAS f32x4* gp = (GAS f32x4*)(F.GW + (size_t)tok * (PH * PK) + hd * PK);
#pragma unroll
        for (int q = 0; q < 4; ++q) { v4u iv; iv.x = (unsigned)fe[4 * q]; iv.y = (unsigned)fe[4 * q + 1]; iv.z = (unsigned)fe[4 * q + 2]; iv.w = (unsigned)fe[4 * q + 3]; ip[q] = iv;
            f32x4 gv; gv.x = ev[4 * q] * inv; gv.y = ev[4 * q + 1] * inv; gv.z = ev[4 * q + 2] * inv; gv.w = ev[4 * q + 3] * inv; gp[q] = gv; }
    }
}
DI void route_phase(Frame& F) {
    LAS unsigned* wl = (LAS unsigned*)(F.lds + RING_OFF + F.wave * 16384);
    const int gw = F.vcu * NWAVES + F.wave, NGW = F.G * NWAVES;
    for (int wt = gw; wt < (M / 32) * PH; wt += NGW) route_task(F, wl, wt >> 3, wt & 7);
}

DI float gelu_erf(float v) { return 0.5f * v * (1.f + erff(v * 0.70710678118654752f)); }
DI void peer_gather_phase(Frame& F) {
    LAS float* act = (LAS float*)(F.lds + RING_OFF);
    LAS float* red = act + 128;
    const int lane = F.lane, w = F.wave;
    for (int m = F.vcu; m < M; m += F.G) {
        const int b = m / SEQ;
        int idxv = 0; float gv = 0.f;
        if (lane < 16) { idxv = F.IDX[(size_t)m * 128 + 16 * w + lane]; gv = F.GW[(size_t)m * 128 + 16 * w + lane]; }
        f32x4 hv[16];
        { const GAS unsigned long long* hp = (const GAS unsigned long long*)(F.H + (size_t)m * D) + lane;
#pragma unroll
          for (int j = 0; j < 16; ++j) { const unsigned long long q = hp[64 * j]; const unsigned lo = (unsigned)q, hi = (unsigned)(q >> 32);
              hv[j].x = bflo(lo); hv[j].y = bfhi(lo); hv[j].z = bflo(hi); hv[j].w = bfhi(hi); } }
        float actv = 0.f;
#pragma unroll 2
        for (int k = 0; k < 16; ++k) {
            const int e = __shfl(idxv, k);
            const GAS f32x4* up = (const GAS f32x4*)(F.u_exp + (size_t)e * D) + lane;
            float dsum = 0.f;
#pragma unroll
            for (int j = 0; j < 16; ++j) { const f32x4 u = up[64 * j]; dsum += (u.x * hv[j].x + u.y * hv[j].y) + (u.z * hv[j].z + u.w * hv[j].w); }
            dsum = wave_sum(dsum);
            if (lane == k) actv = gelu_erf(dsum) * gv;
        }
        __syncthreads();
        if (lane < 16) act[16 * w + lane] = actv;
        __syncthreads();
        const int iv0 = F.IDX[(size_t)m * 128 + lane], iv1 = F.IDX[(size_t)m * 128 + 64 + lane];
        f32x4 y0 = {0.f, 0.f, 0.f, 0.f}, y1 = y0;
        const int colb = 512 * w + 4 * lane;
#pragma unroll 8
        for (int e = 0; e < 128; ++e) {
            const int id = (e < 64) ? __shfl(iv0, e) : __shfl(iv1, e - 64);
            const float a = act[e];
            const GAS f32x4* vp = (const GAS f32x4*)(F.v_exp + (size_t)id * D + colb);
            y0 += a * vp[0]; y1 += a * vp[64];
        }
        const f32x4 xa = *(const GAS f32x4*)(F.X1 + (size_t)m * D + colb), xb = *(const GAS f32x4*)(F.X1 + (size_t)m * D + colb + 256);
        const f32x4 ga = *(const GAS f32x4*)(F.MOD + (size_t)b * MODW + 5 * D + colb), gb = *(const GAS f32x4*)(F.MOD + (size_t)b * MODW + 5 * D + colb + 256);
        const f32x4 za = xa + ga * y0, zb = xb + gb * y1;
        float ss = (za.x * za.x + za.y * za.y) + (za.z * za.z + za.w * za.w) + (zb.x * zb.x + zb.y * zb.y) + (zb.z * zb.z + zb.w * zb.w);
        ss = wave_sum(ss);
        if (lane == 0) red[w] = ss;
        __syncthreads();
        float tot = 0.f;
#pragma unroll
        for (int q = 0; q < 8; ++q) tot += red[q];
        const float rstd = 1.f / sqrtf(tot * (1.f / D) + EPS);
        const f32x4 fa = *(const GAS f32x4*)(F.g_final + colb), fb = *(const GAS f32x4*)(F.g_final + colb + 256);
        *(GAS f32x4*)(F.out + (size_t)m * D + colb) = za * rstd * fa;
        *(GAS f32x4*)(F.out + (size_t)m * D + colb + 256) = zb * rstd * fb;
    }
}
struct Args { const float* in[17]; float* out; unsigned char* ws; int ph_lo, ph_hi, li, pad; };
__global__ void __launch_bounds__(NWAVES * 64, 2) peer_block_fwd(Args args) {
    extern __shared__ __attribute__((aligned(16))) unsigned char lds[];
    Frame F;
    F.lds = (LAS unsigned char*)lds;
    F.MISC = (volatile LAS unsigned*)(F.lds + MISC_OFF);
    F.tid = threadIdx.x; F.lane = F.tid & 63; F.wave = __builtin_amdgcn_readfirstlane(F.tid >> 6);
    F.G = gridDim.x; { const int bx = blockIdx.x; F.vcu = (F.G % 8 == 0) ? (bx % 8) * (F.G / 8) + bx / 8 : bx; }
    unsigned char* ws = args.ws;
    F.ctl = (gu32*)(ws + WS_CTL);
    F.x = args.in[0]; F.c = args.in[1]; F.w_ada = args.in[2]; F.b_ada = args.in[3]; F.g1 = args.in[4]; F.w_in = args.in[5]; F.g_ah = args.in[6]; F.w_pool = args.in[7]; F.s_pool = args.in[8];
    F.w_out = args.in[9]; F.g2 = args.in[10]; F.w_query = args.in[11]; F.sk1 = args.in[12]; F.sk2 = args.in[13]; F.u_exp = args.in[14]; F.v_exp = args.in[15]; F.g_final = args.in[16];
    F.out = args.out;
    F.MOD = (float*)(ws + WS_MOD); F.SK = (bf16*)(ws + WS_SK); F.WPT = (bf16*)(ws + WS_WPT); F.WQT = (bf16*)(ws + WS_WQT); F.WOUTT = (bf16*)(ws + WS_WOUTT); F.WINT = (bf16*)(ws + WS_WINT);
    F.H = (bf16*)(ws + WS_H); F.PROJ = (bf16*)(ws + WS_PROJ); F.CAT = (bf16*)(ws + WS_CAT); F.DP = (bf16*)(ws + WS_DP); F.QP = (bf16*)(ws + WS_QP); F.X1 = (float*)(ws + WS_X1);
    F.IDX = (int*)(ws + WS_IDX); F.GW = (float*)(ws + WS_GW);
    for (int u = F.tid; u < (LDS_BYTES - LDSCTL_OFF) / 4; u += NWAVES * 64) ((LAS unsigned*)(F.lds + LDSCTL_OFF))[u] = 0u;
    __syncthreads();
    XcdBarrier bar; bar.bar = (unsigned*)(F.ctl + CW_BAR); bar.x = 0; bar.st = nullptr;
    if (N_LAUNCHES == 1) bar = xcd_barrier_post((unsigned*)(F.ctl + CW_BAR), F.MISC + 8);
    const int lo = args.ph_lo, hi = args.ph_hi;
#ifndef PHASE_MASK
#define PHASE_MASK 0x3ff
#endif
#define IN(k) (lo <= (k) && (k) < hi && ((PHASE_MASK >> (k)) & 1))
#define SEAM(k) do { if (IN(k) && IN((k) + 1)) xcd_barrier(bar); } while (0)
    const int NOGRP = 1 << 30;

    if (IN(0)) { ph0_prologue(F); SEAM(0); }
    if (IN(1)) { norm_phase(F, F.x, F.g1, 0, 1, F.H); SEAM(1); }
    if (IN(2)) {
        pg8::Gemm g{F.H, F.WINT, M, NPROJ, D, NOGRP, 0}; pg8::StaticOrder S; S.init(M, NPROJ, F.G, (int)blockIdx.x);
        pg8::EpiBf16<0> E{F.PROJ, NPROJ, nullptr, 0, 0, 1.f};
        pg8::gemm_phase<pg8::EpiBf16<0>, pg8::StaticOrder, true, true>(F.lds + RING_OFF, g, S, E);
        SEAM(2);
    }
    if (IN(3)) { pool_diff_phase(F); attn_phase(F); SEAM(3); }
    if (IN(4)) {
        pg8::Gemm g{F.DP, F.WPT, M, DPOOL, PGRP, 2, (size_t)M * PGRP * 2}; pg8::StaticOrder S; S.init(M, DPOOL, F.G, (int)blockIdx.x);
        pg8::EpiScaleBf16 E{F.CAT + DATTN, D, F.s_pool};
        pg8::gemm_phase<pg8::EpiScaleBf16, pg8::StaticOrder, true, true>(F.lds + RING_OFF, g, S, E);
        SEAM(4);
    }
    if (IN(5)) {
        pg8::Gemm g{F.CAT, F.WOUTT, M, D, D, NOGRP, 0}; pg8::StaticOrder S; S.init(M, D, F.G, (int)blockIdx.x);
        pg8::EpiResid E{F.x, F.X1, D, F.MOD + 2 * D, MODW, SEQ};
        pg8::gemm_phase<pg8::EpiResid, pg8::StaticOrder, true, true>(F.lds + RING_OFF, g, S, E);
        SEAM(5);
    }
    if (IN(6)) { norm_phase(F, F.X1, F.g2, 3, 4, F.H); SEAM(6); }
    if (IN(7)) {
        pg8::Gemm g{F.H, F.WQT, M, NQ, D, NOGRP, 0}; pg8::StaticOrder S; S.init(M, NQ, F.G, (int)blockIdx.x);
        pg8::EpiBf16<0> E{F.QP, NQ, nullptr, 0, 0, 1.f};
        pg8::gemm_phase<pg8::EpiBf16<0>, pg8::StaticOrder, true, true>(F.lds + RING_OFF, g, S, E);
        SEAM(7);
    }
    if (IN(8)) { route_phase(F); SEAM(8); }
    if (IN(9)) { peer_gather_phase(F); }
#undef IN
#undef SEAM
}

extern "C" void kernel_launch(void* const* d_in, const int* in_sizes, int n_in, void* d_out, int out_size, void* d_ws, size_t ws_size, hipStream_t stream) {
    static int grid = 0;
    if (grid == 0) {
        if (n_in != 17 || in_sizes[0] != M * D || out_size != M * D || ws_size < WS_END) { fprintf(stderr, "kernel_launch: built for 17 inputs, x/out of %d floats, >= %zu bytes of workspace; got n_in %d, in0 %d, out %d, ws %zu; nothing launched\n", M * D, (size_t)WS_END, n_in, n_in > 0 ? in_sizes[0] : -1, out_size, ws_size); grid = -1; return; }
        int dev = 0, cus = 0, per_cu = 0;
        if (hipGetDevice(&dev) != hipSuccess || hipDeviceGetAttribute(&cus, hipDeviceAttributeMultiprocessorCount, dev) != hipSuccess) { fprintf(stderr, "kernel_launch: hipGetDevice / hipDeviceGetAttribute failed\n"); grid = -1; return; }
        if (hipFuncSetAttribute((const void*)peer_block_fwd, hipFuncAttributeMaxDynamicSharedMemorySize, LDS_BYTES) != hipSuccess) { fprintf(stderr, "kernel_launch: hipFuncSetAttribute failed\n"); grid = -1; return; }
        if (hipOccupancyMaxActiveBlocksPerMultiprocessor(&per_cu, (const void*)peer_block_fwd, NWAVES * 64, LDS_BYTES) != hipSuccess || per_cu < 1)
            fprintf(stderr, "kernel_launch: note: occupancy query reports %d workgroups per CU\n", per_cu);
        (void)hipGetLastError();
        grid = cus;
    }
    if (grid < 0) return;
    if (hipMemsetAsync((char*)d_ws + WS_CTL, 0, CTL_ZERO_BYTES, stream) != hipSuccess) { fprintf(stderr, "kernel_launch: hipMemsetAsync failed\n"); return; }
    Args a{};
    for (int i = 0; i < 17; ++i) a.in[i] = (const float*)d_in[i];
    a.out = (float*)d_out; a.ws = (unsigned char*)d_ws;
    for (int li = 0; li < N_LAUNCHES; ++li) {
        a.ph_lo = (N_LAUNCHES == 1) ? 0 : li; a.ph_hi = (N_LAUNCHES == 1) ? NPHASE : li + 1; a.li = li;
        hipLaunchKernelGGL(peer_block_fwd, dim3(grid), dim3(NWAVES * 64), LDS_BYTES, stream, a);
        const hipError_t le = hipPeekAtLastError();
        if (le != hipSuccess) { fprintf(stderr, "kernel_launch: launch %d failed: %s\n", li, hipGetErrorName(le)); break; }
    }
}
```

```cpp
#include <hip/hip_runtime.h>
#include <cstdio>
#include <cstdint>
namespace pg8 {
#define PG8_LAS __attribute__((address_space(3)))
typedef unsigned short bf16_t;
typedef short bf16x8 __attribute__((ext_vector_type(8)));
typedef float f32x4 __attribute__((ext_vector_type(4)));
typedef unsigned u32x4 __attribute__((ext_vector_type(4)));
constexpr int BM = 256, BK = 64, HALF = 128, HTB = HALF * BK * 2  , STAGE_BYTES = 8 * HTB, NXCD = 8, WGM = 8;

__host__ __device__ __forceinline__ int lds_byte(int r, int c) { const int st = (r >> 4) * 2 + (c >> 5), rr = r & 15, cc = c & 31, ob = rr * 64 + cc * 2; return st * 1024 + (ob ^ (((ob >> 9) & 1) << 5)); }
__host__ __device__ __forceinline__ void stage_rc(int b, int& R, int& C) { const int st = b / 1024, sb = b % 1024, swz = sb ^ (((sb >> 9) & 1) << 5); R = (st >> 1) * 16 + swz / 64; C = (st & 1) * 32 + (swz % 64) / 2; }
__host__ __device__ __forceinline__ int perm32(int rho) { const int n = rho >> 4, i = rho & 15; return 8 * (i >> 2) + 4 * n + (i & 3); }

struct Unit { int pm, pn; };
struct Gemm { const bf16_t* A; const bf16_t* Bt; int M, N, K; int png; size_t agb; int lda, ldb; };

struct StaticOrder {
    int nM, nN, nwg, G, c;
    __host__ __device__ void init(int M, int N, int G_, int c_) { nM = M / BM; nN = N / BM; nwg = nM * nN; G = G_; c = c_; }
    __host__ __device__ bool next(int i, Unit& u) const {
        const long L = (long)i * G + c; if (L >= nwg) return false;
        int wgid = (int)L; { const int q = nwg / NXCD, r = nwg % NXCD, xcd = wgid % NXCD, off = wgid / NXCD; wgid = (xcd < r ? xcd * (q + 1) : r * (q + 1) + (xcd - r) * q) + off; }
        const int nig = WGM * nN, gid = wgid / nig, fm = gid * WGM, gsz = (nM - fm) < WGM ? (nM - fm) : WGM;
        u.pm = fm + ((wgid % nig) % gsz); u.pn = (wgid % nig) / gsz; return true;
    }
    __device__ __forceinline__ void a_ready(const Unit&) const {}
    __device__ __forceinline__ void done(const Unit&) const {}
};

__device__ __forceinline__ unsigned cvt_pk_bf16(float lo, float hi) { unsigned r; asm volatile("v_cvt_pk_bf16_f32 %0, %1, %2" : "=v"(r) : "v"(lo), "v"(hi)); return r; }
typedef float f32x2 __attribute__((ext_vector_type(2)));
__device__ __forceinline__ f32x2 gelu_pk(f32x2 v) {
    const f32x2 av = __builtin_elementwise_abs(v), d = av * 0.2316418882f + 1.0f;
    f32x2 t; t.x = __builtin_amdgcn_rcpf(d.x); t.y = __builtin_amdgcn_rcpf(d.y);
    f32x2 q = t * 0.5307027145f + (-0.7265760135f); q = q * t + 0.7107068705f; q = q * t + (-0.142248368f); q = q * t + 0.127414796f; q = q * t;
    const f32x2 s = (v * v) * (-0.72134752044f);
    f32x2 e; e.x = __builtin_amdgcn_exp2f(s.x); e.y = __builtin_amdgcn_exp2f(s.y);
    const f32x2 m = v * (q * e), r = v - m;
    f32x2 o; o.x = v.x < 0.f ? m.x : r.x; o.y = v.y < 0.f ? m.y : r.y; return o;
}

template <int ACT  > struct EpiBf16 {
    static constexpr bool PERM = true, AFTER_DRAIN = false; static_assert(ACT == 0 || ACT == 1, "EpiBf16: ACT is 0 (none) or 1 (gelu_pk)");
    bf16_t* O; int ldc; const float* bias; int split_cols; size_t split_stride; float scale0;
    __device__ __forceinline__ void operator()(const f32x4 (&acc)[2][2][4][2], const Unit& u, int wr, int wc, int fr, int fq) const {
        const int row0 = u.pm * BM + wr * 64 + fr; int colt = u.pn * BM; bf16_t* base = O;
        float sc = 1.f; if (split_cols) { const int t = colt / split_cols; base += (size_t)t * split_stride; colt -= t * split_cols; if (t == 0) sc = scale0; }
        const int col0 = colt + wc * 32 + 8 * fq, bcol0 = u.pn * BM + wc * 32 + 8 * fq;
        f32x4 bv[2][2];
#pragma unroll
        for (int bj = 0; bj < 2; ++bj)
#pragma unroll
            for (int n = 0; n < 2; ++n) bv[bj][n] = bias ? *(const f32x4*)(bias + bcol0 + bj * HALF + 4 * n) : (f32x4){0.f, 0.f, 0.f, 0.f};
#pragma unroll
        for (int ai = 0; ai < 2; ++ai)
#pragma unroll
            for (int m = 0; m < 4; ++m) { bf16_t* rowp = base + (size_t)(row0 + ai * HALF + m * 16) * ldc + col0;
#pragma unroll
                for (int bj = 0; bj < 2; ++bj) { f32x4 v0 = acc[ai][bj][m][0] + bv[bj][0], v1 = acc[ai][bj][m][1] + bv[bj][1];
                    if (ACT == 1) { f32x2 a = gelu_pk((f32x2){v0[0], v0[1]}), b = gelu_pk((f32x2){v0[2], v0[3]}), c = gelu_pk((f32x2){v1[0], v1[1]}), d = gelu_pk((f32x2){v1[2], v1[3]});
                        v0 = (f32x4){a.x, a.y, b.x, b.y}; v1 = (f32x4){c.x, c.y, d.x, d.y}; }
                    v0 = v0 * sc; v1 = v1 * sc; u32x4 w; w.x = cvt_pk_bf16(v0[0], v0[1]); w.y = cvt_pk_bf16(v0[2], v0[3]); w.z = cvt_pk_bf16(v1[0], v1[1]); w.w = cvt_pk_bf16(v1[2], v1[3]);
                    *(u32x4*)(rowp + bj * HALF) = w; } }
    }
};
constexpr int M_ROWS = 16384;
struct EpiScaleBf16 {
    static constexpr bool PERM = true, AFTER_DRAIN = false;
    bf16_t* O; int ldc; const float* cs; int cs_bstride; int rows_per_batch;
    __device__ __forceinline__ void operator()(const f32x4 (&acc)[2][2][4][2], const Unit& u, int wr, int wc, int fr, int fq) const {
        const int row0 = u.pm * BM + wr * 64 + fr, col0 = u.pn * BM + wc * 32 + 8 * fq;
        const float* cs = this->cs + (size_t)((u.pm * BM) / rows_per_batch) * cs_bstride;
        f32x4 sv[2][2];
#pragma unroll
        for (int bj = 0; bj < 2; ++bj)
#pragma unroll
            for (int n = 0; n < 2; ++n) sv[bj][n] = *(const f32x4*)(cs + col0 + bj * HALF + 4 * n);
#pragma unroll
        for (int ai = 0; ai < 2; ++ai)
#pragma unroll
            for (int m = 0; m < 4; ++m) { bf16_t* rowp = O + (size_t)(row0 + ai * HALF + m * 16) * ldc + col0;
#pragma unroll
                for (int bj = 0; bj < 2; ++bj) { const f32x4 v0 = acc[ai][bj][m][0] * sv[bj][0], v1 = acc[ai][bj][m][1] * sv[bj][1];
                    u32x4 w; w.x = cvt_pk_bf16(v0[0], v0[1]); w.y = cvt_pk_bf16(v0[2], v0[3]); w.z = cvt_pk_bf16(v1[0], v1[1]); w.w = cvt_pk_bf16(v1[2], v1[3]);
                    *(u32x4*)(rowp + bj * HALF) = w; } }
    }
};
struct EpiResid {
    static constexpr bool PERM = false, AFTER_DRAIN = false;
    const float* X; float* O; int ldc; const float* gate; int gate_bstride; int rows_per_batch;
    __device__ __forceinline__ void operator()(const f32x4 (&acc)[2][2][4][2], const Unit& u, int wr, int wc, int fr, int fq) const {
        const int row0 = u.pm * BM + wr * 64 + fr, col0 = u.pn * BM + wc * 32 + 4 * fq;
        const float* gp = gate + (size_t)((u.pm * BM) / rows_per_batch) * gate_bstride + col0;
        f32x4 gv[2][2];
#pragma unroll
        for (int bj = 0; bj < 2; ++bj)
#pragma unroll
            for (int n = 0; n < 2; ++n) gv[bj][n] = *(const f32x4*)(gp + bj * HALF + 16 * n);
#pragma unroll
        for (int ai = 0; ai < 2; ++ai)
#pragma unroll
            for (int m = 0; m < 4; ++m) { const size_t ro = (size_t)(row0 + ai * HALF + m * 16) * ldc + col0;
#pragma unroll
                for (int bj = 0; bj < 2; ++bj)
#pragma unroll
                    for (int n = 0; n < 2; ++n) { const f32x4 xv = *(const f32x4*)(X + ro + bj * HALF + 16 * n);
                        *(f32x4*)(O + ro + bj * HALF + 16 * n) = xv + gv[bj][n] * acc[ai][bj][m][n]; } }
    }
};
struct EpiProjHM {
    static constexpr bool PERM = true, AFTER_DRAIN = false;
    bf16_t* QKV; bf16_t* P; int seq, nheads, hd, dattn, dpool;
    __device__ __forceinline__ void operator()(const f32x4 (&acc)[2][2][4][2], const Unit& u, int wr, int wc, int fr, int fq) const {
        const int row0 = u.pm * BM + wr * 64 + fr, colt = u.pn * BM, cin = wc * 32 + 8 * fq;
        const int sec = colt / dattn;
#pragma unroll
        for (int ai = 0; ai < 2; ++ai)
#pragma unroll
            for (int m = 0; m < 4; ++m) { const int row = row0 + ai * HALF + m * 16, b = row / seq, t = row - b * seq;
#pragma unroll
                for (int bj = 0; bj < 2; ++bj) { const f32x4 v0 = acc[ai][bj][m][0], v1 = acc[ai][bj][m][1];
                    u32x4 w; w.x = cvt_pk_bf16(v0[0], v0[1]); w.y = cvt_pk_bf16(v0[2], v0[3]); w.z = cvt_pk_bf16(v1[0], v1[1]); w.w = cvt_pk_bf16(v1[2], v1[3]);
                    bf16_t* dst;
                    if (sec < 3) { const int head = (colt - sec * dattn) / hd + bj; dst = QKV + (size_t)sec * seq * (size_t)(dattn * (M_ROWS / seq)) + ((size_t)(b * nheads + head) * seq + t) * hd + cin; }
                    else dst = P + (size_t)row * dpool + (colt - 3 * dattn) + bj * HALF + cin;
                    *(u32x4*)dst = w; } }
    }
};
struct EpiResidBf16 {
    static constexpr bool PERM = true, AFTER_DRAIN = false;
    const float* X; bf16_t* O; int ldc; const float* gate; int gate_bstride; int rows_per_batch;
    __device__ __forceinline__ void operator()(const f32x4 (&acc)[2][2][4][2], const Unit& u, int wr, int wc, int fr, int fq) const {
        const int row0 = u.pm * BM + wr * 64 + fr, col0 = u.pn * BM + wc * 32 + 8 * fq;
        const float* gp = gate + (size_t)((u.pm * BM) / rows_per_batch) * gate_bstride + col0;
        f32x4 gv[2][2];
#pragma unroll
        for (int bj = 0; bj < 2; ++bj)
#pragma unroll
            for (int n = 0; n < 2; ++n) gv[bj][n] = *(const f32x4*)(gp + bj * HALF + 4 * n);
#pragma unroll
        for (int ai = 0; ai < 2; ++ai)
#pragma unroll
            for (int m = 0; m < 4; ++m) { const size_t ro = (size_t)(row0 + ai * HALF + m * 16) * ldc + col0;
#pragma unroll
                for (int bj = 0; bj < 2; ++bj) { const f32x4 x0 = *(const f32x4*)(X + ro + bj * HALF), x1 = *(const f32x4*)(X + ro + bj * HALF + 4);
                    const f32x4 v0 = x0 + gv[bj][0] * acc[ai][bj][m][0], v1 = x1 + gv[bj][1] * acc[ai][bj][m][1];
                    u32x4 w; w.x = cvt_pk_bf16(v0[0], v0[1]); w.y = cvt_pk_bf16(v0[2], v0[3]); w.z = cvt_pk_bf16(v1[0], v1[1]); w.w = cvt_pk_bf16(v1[2], v1[3]);
                    *(u32x4*)(O + ro + bj * HALF) = w; } }
    }
};

template <class Epi, class Sched, bool ALIGN_EPI = false, bool SP2 = false>
__device__ __forceinline__ void gemm_phase(PG8_LAS unsigned char* lds, const Gemm g, const Sched& S, const Epi& E) {
    const int tid = threadIdx.x, wid = __builtin_amdgcn_readfirstlane(tid >> 6), lane = tid & 63, wr = wid >> 2, wc = wid & 3, fr = lane & 15, fq = lane >> 4;
    const int K = g.K, nt = K / BK;
    unsigned voffA[2], voffB[2];
#pragma unroll
    for (int i = 0; i < 2; ++i) { int R, C; stage_rc(tid * 16 + i * 8192, R, C); const int Rb = Epi::PERM ? ((R & ~31) + perm32(R & 31)) : R;
        voffA[i] = (unsigned)(R * g.lda + C) * 2u; voffB[i] = (unsigned)(Rb * g.ldb + C) * 2u; }
    const size_t kstep = (size_t)(BK * 2);
    const size_t hstepA = (size_t)HALF * g.lda * 2, hstepB = (size_t)HALF * g.ldb * 2;
    const size_t tstepA = 2 * hstepA, tstepB = 2 * hstepB;
    const unsigned ldsw = (unsigned)wid * 1024u;
    const int aoff = lds_byte(wr * 64 + fr, fq * 8), boff = lds_byte(wc * 32 + fr, fq * 8);
#define PG8_SA(b, h) (((b) * 2 + (h)) * HTB)
#define PG8_SB(b, h) ((4 + (b) * 2 + (h)) * HTB)
#define PG8_STAGE(bufoff, gbase, voff) do { _Pragma("unroll") for (int _i = 0; _i < 2; ++_i) \
        __builtin_amdgcn_global_load_lds((const unsigned*)((const char*)(gbase) + (voff)[_i]), (PG8_LAS unsigned*)(lds + (bufoff) + ldsw + _i * 8192), 16, 0, 0); } while (0)
#define PG8_LDA(dst, b, h) do { _Pragma("unroll") for (int m = 0; m < 4; ++m) _Pragma("unroll") for (int k = 0; k < 2; ++k) dst[m][k] = *(const PG8_LAS bf16x8*)(lds + PG8_SA(b, h) + aoff + m * 2048 + k * 1024); } while (0)
#define PG8_LDB(dst, b, h) do { _Pragma("unroll") for (int n = 0; n < 2; ++n) _Pragma("unroll") for (int k = 0; k < 2; ++k) dst[n][k] = *(const PG8_LAS bf16x8*)(lds + PG8_SB(b, h) + boff + n * 2048 + k * 1024); } while (0)
#define PG8_MMA(ai, bj, At, Bt) do { __builtin_amdgcn_s_setprio(1); _Pragma("unroll") for (int m = 0; m < 4; ++m) _Pragma("unroll") for (int n = 0; n < 2; ++n) _Pragma("unroll") for (int k = 0; k < 2; ++k) \
        acc[ai][bj][m][n] = __builtin_amdgcn_mfma_f32_16x16x32_bf16(Bt[n][k], At[m][k], acc[ai][bj][m][n], 0, 0, 0); __builtin_amdgcn_s_setprio(0); } while (0)
#define PG8_WAIT_V(n) asm volatile("s_waitcnt vmcnt(" #n ")" ::: "memory")
#define PG8_WAIT_L(n) asm volatile("s_waitcnt lgkmcnt(" #n ")" ::: "memory")
#define PG8_BAR __builtin_amdgcn_s_barrier()
#define PG8_SCHED __builtin_amdgcn_sched_barrier(0)
    Unit cur, nxt; int ui = 0;
    if (!S.next(0, cur)) return;
    f32x4 acc[2][2][4][2];
#pragma unroll
    for (int a = 0; a < 2; ++a)
#pragma unroll
        for (int b = 0; b < 2; ++b)
#pragma unroll
            for (int m = 0; m < 4; ++m)
#pragma unroll
                for (int n = 0; n < 2; ++n) acc[a][b][m][n] = (f32x4){0.f, 0.f, 0.f, 0.f};
    bf16x8 At[4][2], B0[2][2], B1[2][2];
    const char* cA = (const char*)g.A + (size_t)cur.pm * tstepA + (size_t)(cur.pn / g.png) * g.agb; const char* cB = (const char*)g.Bt + (size_t)cur.pn * tstepB;
    S.a_ready(cur);
    if constexpr (SP2) {
        PG8_STAGE(PG8_SB(0, 0), cB, voffB); PG8_STAGE(PG8_SB(0, 1), cB + hstepB, voffB); PG8_STAGE(PG8_SA(0, 0), cA, voffA); PG8_STAGE(PG8_SA(0, 1), cA + hstepA, voffA);
        if (wr == 1) PG8_BAR;
        PG8_WAIT_V(2); PG8_BAR;
        PG8_STAGE(PG8_SB(1, 0), cB + kstep, voffB); PG8_STAGE(PG8_SA(1, 0), cA + kstep, voffA); PG8_STAGE(PG8_SB(1, 1), cB + hstepB + kstep, voffB);
        PG8_WAIT_V(6); PG8_BAR;
    } else {
        PG8_STAGE(PG8_SB(0, 0), cB, voffB); PG8_STAGE(PG8_SA(0, 0), cA, voffA); PG8_STAGE(PG8_SB(0, 1), cB + hstepB, voffB); PG8_STAGE(PG8_SA(0, 1), cA + hstepA, voffA);
        if (wr == 1) PG8_BAR;
        PG8_WAIT_V(4); PG8_BAR;
        PG8_STAGE(PG8_SB(1, 0), cB + kstep, voffB); PG8_STAGE(PG8_SA(1, 0), cA + kstep, voffA); PG8_STAGE(PG8_SB(1, 1), cB + hstepB + kstep, voffB);
        PG8_WAIT_V(6); PG8_BAR;
    }
    for (;;) {
        const bool has_next = S.next(ui + 1, nxt);
        const char* nA = has_next ? (const char*)g.A + (size_t)nxt.pm * tstepA + (size_t)(nxt.pn / g.png) * g.agb : cA; const char* nB = has_next ? (const char*)g.Bt + (size_t)nxt.pn * tstepB : cB;
        for (int t = 0; t < nt; t += 2) {
            const bool last = (t == nt - 2);
            const char* a1 = cA + (size_t)(t + 1) * kstep;
            const char* a2 = last ? nA : cA + (size_t)(t + 2) * kstep; const char* b2 = last ? nB : cB + (size_t)(t + 2) * kstep;
            const char* a3 = a2 + kstep; const char* b3 = b2 + kstep;
            if (last && has_next) S.a_ready(nxt);
            if constexpr (SP2) {
            PG8_LDB(B0, 0, 0); PG8_LDB(B1, 0, 1); PG8_SCHED; PG8_LDA(At, 0, 0); PG8_STAGE(PG8_SA(1, 1), a1 + hstepA, voffA);
            PG8_WAIT_V(8); PG8_WAIT_L(0); PG8_BAR; PG8_MMA(0, 0, At, B0); PG8_MMA(0, 1, At, B1); PG8_BAR; PG8_SCHED;
            PG8_LDA(At, 0, 1); PG8_STAGE(PG8_SB(0, 0), b2, voffB); PG8_STAGE(PG8_SB(0, 1), b2 + hstepB, voffB); PG8_STAGE(PG8_SA(0, 0), a2, voffA);
            PG8_WAIT_V(8); PG8_WAIT_L(0); PG8_BAR; PG8_MMA(1, 0, At, B0); PG8_MMA(1, 1, At, B1); PG8_BAR; PG8_SCHED;
            PG8_LDB(B0, 1, 0); PG8_LDB(B1, 1, 1); PG8_SCHED; PG8_LDA(At, 1, 0); PG8_STAGE(PG8_SA(0, 1), a2 + hstepA, voffA);
            PG8_WAIT_V(8); PG8_WAIT_L(0); PG8_BAR; PG8_MMA(0, 0, At, B0); PG8_MMA(0, 1, At, B1); PG8_BAR; PG8_SCHED;
            PG8_LDA(At, 1, 1); PG8_STAGE(PG8_SB(1, 0), b3, voffB); PG8_STAGE(PG8_SB(1, 1), b3 + hstepB, voffB); PG8_STAGE(PG8_SA(1, 0), a3, voffA);
            PG8_WAIT_V(8); PG8_WAIT_L(0); PG8_BAR; PG8_MMA(1, 0, At, B0); PG8_MMA(1, 1, At, B1); PG8_BAR; PG8_SCHED;
            } else {
            PG8_LDB(B0, 0, 0); PG8_SCHED; PG8_LDA(At, 0, 0); PG8_STAGE(PG8_SA(1, 1), a1 + hstepA, voffA);
            PG8_WAIT_L(8); PG8_BAR; PG8_WAIT_L(0); PG8_MMA(0, 0, At, B0); PG8_BAR; PG8_SCHED;
            PG8_LDB(B1, 0, 1); PG8_STAGE(PG8_SB(0, 0), b2, voffB);
            PG8_BAR; PG8_WAIT_L(0); PG8_MMA(0, 1, At, B1); PG8_BAR;
            PG8_LDA(At, 0, 1); PG8_STAGE(PG8_SA(0, 0), a2, voffA);
            PG8_BAR; PG8_WAIT_L(0); PG8_MMA(1, 0, At, B0); PG8_BAR; PG8_SCHED;
            PG8_STAGE(PG8_SB(0, 1), b2 + hstepB, voffB);
            PG8_WAIT_V(6); PG8_BAR; PG8_MMA(1, 1, At, B1); PG8_BAR;
            PG8_LDB(B0, 1, 0); PG8_SCHED; PG8_LDA(At, 1, 0); PG8_STAGE(PG8_SA(0, 1), a2 + hstepA, voffA);
            PG8_WAIT_L(8); PG8_BAR; PG8_WAIT_L(0); PG8_MMA(0, 0, At, B0); PG8_BAR; PG8_SCHED;
            PG8_LDB(B1, 1, 1); PG8_STAGE(PG8_SB(1, 0), b3, voffB);
            PG8_BAR; PG8_WAIT_L(0); PG8_MMA(0, 1, At, B1); PG8_BAR;
            PG8_LDA(At, 1, 1); PG8_STAGE(PG8_SA(1, 0), a3, voffA);
            PG8_BAR; PG8_WAIT_L(0); PG8_MMA(1, 0, At, B0); PG8_BAR; PG8_SCHED;
            PG8_STAGE(PG8_SB(1, 1), b3 + hstepB, voffB);
            PG8_WAIT_V(6); PG8_BAR; PG8_MMA(1, 1, At, B1); PG8_BAR;
            }
        }
        if constexpr (ALIGN_EPI) { if (wr == 0) PG8_BAR; }
        if constexpr (!Epi::AFTER_DRAIN) { E(acc, cur, wr, wc, fr, fq); S.done(cur); }
        if (!has_next) break;
#pragma unroll
        for (int a = 0; a < 2; ++a)
#pragma unroll
            for (int b = 0; b < 2; ++b)
#pragma unroll
                for (int m = 0; m < 4; ++m)
#pragma unroll
                    for (int n = 0; n < 2; ++n) acc[a][b][m][n] = (f32x4){0.f, 0.f, 0.f, 0.f};
        cur = nxt; cA = nA; cB = nB; ++ui;
        if constexpr (ALIGN_EPI) { if (wr == 1) PG8_BAR; }
    }
    PG8_WAIT_V(0);
    if constexpr (!ALIGN_EPI) { if (wr == 0) PG8_BAR; }
    PG8_BAR;
    if constexpr (Epi::AFTER_DRAIN) { E.fused(acc, cur, wr, wc, fr, fq, lds, wid, lane); S.done(cur); }
#undef PG8_SA
#undef PG8_SB
#undef PG8_STAGE
#undef PG8_LDA
#undef PG8_LDB
#undef PG8_MMA
#undef PG8_WAIT_V
#undef PG8_WAIT_L
#undef PG8_BAR
#undef PG8_SCHED
}
}
namespace pg8 {
typedef int i32x4_t __attribute__((ext_vector_type(4)));
typedef int i32x8_t __attribute__((ext_vector_type(8)));
__device__ __forceinline__ i32x8_t cat8(bf16x8 lo, bf16x8 hi) { return __builtin_shufflevector(__builtin_bit_cast(i32x4_t, lo), __builtin_bit_cast(i32x4_t, hi), 0, 1, 2, 3, 4, 5, 6, 7); }
__device__ __forceinline__ f32x4 mma_f8(i32x8_t B, i32x8_t A, f32x4 c) { return __builtin_amdgcn_mfma_scale_f32_16x16x128_f8f6f4(B, A, c, 0, 0, 0, 0, 0, 0); }
struct Order8 {
    int nM, nN, nwg, G, c;
    __device__ void init(int M, int N, int G_, int c_) { nM = M / 256; nN = N / 128; nwg = nM * nN; G = G_; c = c_; }
    __device__ bool next(int i, int& pm, int& pn) const {
        const long L = (long)i * G + c; if (L >= nwg) return false;
        int wgid = (int)L; { const int q = nwg / NXCD, r = nwg % NXCD, xcd = wgid % NXCD, off = wgid / NXCD; wgid = (xcd < r ? xcd * (q + 1) : r * (q + 1) + (xcd - r) * q) + off; }
        const int nig = WGM * nN, gid = wgid / nig, fm = gid * WGM, gsz = (nM - fm) < WGM ? (nM - fm) : WGM;
        pm = fm + ((wgid % nig) % gsz); pn = (wgid % nig) / gsz; return true;
    }
};
struct EpiG8Resid {
    const float* X; bf16_t* O; int ldc; const float* gate; int gate_bstride; int rows_per_batch; const float* sa; float sa_const; const float* sb;
    __device__ __forceinline__ void operator()(const f32x4 (&acc)[4][4], int pm, int pn, int wr, int wc, int fr_, int fq_) const {
        int fr = fr_, fq = fq_; asm volatile("" : "+v"(fr), "+v"(fq));
        const int row0 = pm * 256 + wr * 64 + fr, colb = pn * 128 + wc * 64 + 8 * fq;
        const float* gp = gate + (size_t)((pm * 256) / rows_per_batch) * gate_bstride + colb;
        f32x4 gv[2][2];
#pragma unroll
        for (int g2 = 0; g2 < 2; ++g2)
#pragma unroll
            for (int q = 0; q < 2; ++q) gv[g2][q] = *(const f32x4*)(gp + 32 * g2 + 4 * q) * *(const f32x4*)(sb + colb + 32 * g2 + 4 * q);
#pragma unroll
        for (int m = 0; m < 4; ++m) { const int row = row0 + 16 * m; const size_t ro = (size_t)row * ldc + colb; const float rs = sa ? sa[row] : sa_const;
#pragma unroll
            for (int g2 = 0; g2 < 2; ++g2) { const f32x4 x0 = *(const f32x4*)(X + ro + 32 * g2), x1 = *(const f32x4*)(X + ro + 32 * g2 + 4);
                const f32x4 v0 = x0 + gv[g2][0] * (acc[m][2 * g2] * rs), v1 = x1 + gv[g2][1] * (acc[m][2 * g2 + 1] * rs);
                u32x4 w; w.x = cvt_pk_bf16(v0[0], v0[1]); w.y = cvt_pk_bf16(v0[2], v0[3]); w.z = cvt_pk_bf16(v1[0], v1[1]); w.w = cvt_pk_bf16(v1[2], v1[3]);
                *(u32x4*)(O + ro + 32 * g2) = w; } }
    }
};
template <class Epi>
__device__ __forceinline__ void gemm8_phase(PG8_LAS unsigned char* lds, const unsigned char* A, const unsigned char* B, int M, int N, int K, int lda, int ldb, int G, int cidx, const Epi& E) {
    const int tid = threadIdx.x, wid = __builtin_amdgcn_readfirstlane(tid >> 6), lane = tid & 63, wr = wid >> 1, wc = wid & 1, fr = lane & 15, fq = lane >> 4;
    unsigned voffA[2], voffB[2];
#pragma unroll
    for (int i = 0; i < 2; ++i) { int R, C; stage_rc(tid * 16 + i * 8192, R, C); const int Rb = (R & ~31) + perm32(R & 31);
        voffA[i] = (unsigned)(R * lda + 2 * C); voffB[i] = (unsigned)(Rb * ldb + 2 * C); }
    const unsigned ldsw = (unsigned)wid * 1024u;
    const int aoff = (wr >> 1) * HTB + lds_byte(64 * (wr & 1) + fr, fq * 8), boff = 2 * HTB + lds_byte(64 * wc + fr, fq * 8);
    constexpr int SS = 3 * HTB;
    const int nt = K / 128;
    Order8 S; S.init(M, N, G, cidx);
#define G8_STAGE1(bufoff, gptr, voff) do { _Pragma("unroll") for (int _i = 0; _i < 2; ++_i) \
        __builtin_amdgcn_global_load_lds((const unsigned*)((const char*)(gptr) + (voff)[_i]), (PG8_LAS unsigned*)(lds + (bufoff) + ldsw + _i * 8192), 16, 0, 0); } while (0)
#define G8_STAGE3(s, kt) do { const size_t ko_ = (size_t)(kt) * 128; G8_STAGE1((s) * SS, gA + ko_, voffA); G8_STAGE1((s) * SS + HTB, gA + (size_t)128 * lda + ko_, voffA); G8_STAGE1((s) * SS + 2 * HTB, gB + ko_, voffB); } while (0)
#define G8_LDF(FA, FB, s) do { _Pragma("unroll") for (int m = 0; m < 4; ++m) { const bf16x8 l0_ = *(const PG8_LAS bf16x8*)(lds + (s) * SS + aoff + m * 2048), l1_ = *(const PG8_LAS bf16x8*)(lds + (s) * SS + aoff + m * 2048 + 1024); FA[m] = cat8(l0_, l1_); } \
        _Pragma("unroll") for (int n = 0; n < 4; ++n) { const bf16x8 l0_ = *(const PG8_LAS bf16x8*)(lds + (s) * SS + boff + n * 2048), l1_ = *(const PG8_LAS bf16x8*)(lds + (s) * SS + boff + n * 2048 + 1024); FB[n] = cat8(l0_, l1_); } } while (0)
#define G8_MMA(FA, FB) do { __builtin_amdgcn_s_setprio(1); _Pragma("unroll") for (int m = 0; m < 4; ++m) _Pragma("unroll") for (int n = 0; n < 4; ++n) acc[m][n] = mma_f8(FB[n], FA[m], acc[m][n]); __builtin_amdgcn_s_setprio(0); } while (0)
#define G8_WAIT_V0 asm volatile("s_waitcnt vmcnt(0)" ::: "memory")
#define G8_WAIT_L0 asm volatile("s_waitcnt lgkmcnt(0)" ::: "memory")
#define G8_BAR __builtin_amdgcn_s_barrier()
#define G8_SCHED __builtin_amdgcn_sched_barrier(0)
    for (int ui = 0;; ++ui) {
        int pm, pn; if (!S.next(ui, pm, pn)) break;
        const char* gA = (const char*)A + (size_t)pm * 256 * lda; const char* gB = (const char*)B + (size_t)pn * 128 * ldb;
        f32x4 acc[4][4];
#pragma unroll
        for (int m = 0; m < 4; ++m)
#pragma unroll
            for (int n = 0; n < 4; ++n) acc[m][n] = (f32x4){0.f, 0.f, 0.f, 0.f};
        i32x8_t A0[4], B0[4], A1[4], B1[4];
        G8_BAR;
        G8_STAGE3(0, 0); G8_WAIT_V0; G8_BAR;
        G8_STAGE3(1, 1);
        G8_LDF(A0, B0, 0); G8_WAIT_L0; G8_SCHED;
        for (int kt = 0; kt < nt; kt += 2) {
            G8_WAIT_V0; G8_BAR; G8_SCHED;
            if (kt + 2 < nt) G8_STAGE3(0, kt + 2);
            G8_LDF(A1, B1, 1); G8_SCHED;
            G8_MMA(A0, B0);
            G8_WAIT_L0; G8_SCHED;
            G8_WAIT_V0; G8_BAR; G8_SCHED;
            if (kt + 3 < nt) G8_STAGE3(1, kt + 3);
            if (kt + 2 < nt) G8_LDF(A0, B0, 0);
            G8_SCHED;
            G8_MMA(A1, B1);
            G8_WAIT_L0; G8_SCHED;
        }
        E(acc, pm, pn, wr, wc, fr, fq);
    }
#undef G8_STAGE1
#undef G8_STAGE3
#undef G8_LDF
#undef G8_MMA
#undef G8_WAIT_V0
#undef G8_WAIT_L0
#undef G8_BAR
#undef G8_SCHED
}
struct EpiG8WResid {
    const float* X; bf16_t* O; int ldc; const float* gate; int gate_bstride; int rows_per_batch; const float* sa; float sa_const; const float* sb;
    __device__ __forceinline__ void operator()(const f32x4 (&acc)[8][4], int pm, int pn, int wr, int wc, int fr_, int fq_) const {
        int fr = fr_, fq = fq_; asm volatile("" : "+v"(fr), "+v"(fq));
        const int row0 = pm * 256 + wr * 128 + fr, colb = pn * 256 + wc * 64 + 8 * fq;
        const float* gp = gate + (size_t)((pm * 256) / rows_per_batch) * gate_bstride + colb;
        f32x4 gv[2][2];
#pragma unroll
        for (int g2 = 0; g2 < 2; ++g2)
#pragma unroll
            for (int q = 0; q < 2; ++q) gv[g2][q] = *(const f32x4*)(gp + 32 * g2 + 4 * q) * *(const f32x4*)(sb + colb + 32 * g2 + 4 * q);
#pragma unroll
        for (int m = 0; m < 8; ++m) { const int row = row0 + 16 * m; const size_t ro = (size_t)row * ldc + colb; const float rs = sa ? sa[row] : sa_const;
#pragma unroll
            for (int g2 = 0; g2 < 2; ++g2) { const f32x4 x0 = *(const f32x4*)(X + ro + 32 * g2), x1 = *(const f32x4*)(X + ro + 32 * g2 + 4);
                const f32x4 v0 = x0 + gv[g2][0] * (acc[m][2 * g2] * rs), v1 = x1 + gv[g2][1] * (acc[m][2 * g2 + 1] * rs);
                u32x4 w; w.x = cvt_pk_bf16(v0[0], v0[1]); w.y = cvt_pk_bf16(v0[2], v0[3]); w.z = cvt_pk_bf16(v1[0], v1[1]); w.w = cvt_pk_bf16(v1[2], v1[3]);
                *(u32x4*)(O + ro + 32 * g2) = w; } }
    }
};
template <class Epi>
__device__ __forceinline__ void gemm8w_phase(PG8_LAS unsigned char* lds, const unsigned char* A, const unsigned char* B, int M, int N, int K, int lda, int ldb, int G, int cidx, const Epi& E) {
    const int tid = threadIdx.x, wid = __builtin_amdgcn_readfirstlane(tid >> 6), lane = tid & 63, wr = wid >> 2, wc = wid & 3, fr = lane & 15, fq = lane >> 4;
    unsigned voffA[2], voffB[2];
#pragma unroll
    for (int i = 0; i < 2; ++i) { int R, C; stage_rc(tid * 16 + i * 8192, R, C); const int Rb = (R & ~31) + perm32(R & 31);
        voffA[i] = (unsigned)(R * lda + 2 * C); voffB[i] = (unsigned)(Rb * ldb + 2 * C); }
    const unsigned ldsw = (unsigned)wid * 1024u;
    const int aoff = wr * HTB + lds_byte(fr, fq * 8), boff = (2 + (wc >> 1)) * HTB + lds_byte(64 * (wc & 1) + fr, fq * 8);
    constexpr int SS = 4 * HTB;
    const int nt = K / 128;
    StaticOrder S; S.init(M, N, G, cidx);
#define G8_STAGE1(bufoff, gptr, voff) do { _Pragma("unroll") for (int _i = 0; _i < 2; ++_i) \
        __builtin_amdgcn_global_load_lds((const unsigned*)((const char*)(gptr) + (voff)[_i]), (PG8_LAS unsigned*)(lds + (bufoff) + ldsw + _i * 8192), 16, 0, 0); } while (0)
#define G8_STAGE4(s, kt) do { const size_t ko_ = (size_t)(kt) * 128; G8_STAGE1((s) * SS, gA + ko_, voffA); G8_STAGE1((s) * SS + HTB, gA + (size_t)128 * lda + ko_, voffA); \
        G8_STAGE1((s) * SS + 2 * HTB, gB + ko_, voffB); G8_STAGE1((s) * SS + 3 * HTB, gB + (size_t)128 * ldb + ko_, voffB); } while (0)
#define G8_LD4(F, off) do { _Pragma("unroll") for (int q_ = 0; q_ < 4; ++q_) { const bf16x8 l0_ = *(const PG8_LAS bf16x8*)(lds + (off) + q_ * 2048), l1_ = *(const PG8_LAS bf16x8*)(lds + (off) + q_ * 2048 + 1024); F[q_] = cat8(l0_, l1_); } } while (0)
#define G8_MMA4(h) do { __builtin_amdgcn_s_setprio(1); _Pragma("unroll") for (int m = 0; m < 4; ++m) _Pragma("unroll") for (int n = 0; n < 4; ++n) acc[4 * (h) + m][n] = mma_f8(FB[n], FA[m], acc[4 * (h) + m][n]); __builtin_amdgcn_s_setprio(0); } while (0)
#define G8_WAIT_V0 asm volatile("s_waitcnt vmcnt(0)" ::: "memory")
#define G8_WAIT_L0 asm volatile("s_waitcnt lgkmcnt(0)" ::: "memory")
#define G8_BAR __builtin_amdgcn_s_barrier()
#define G8_SCHED __builtin_amdgcn_sched_barrier(0)
    for (int ui = 0;; ++ui) {
        Unit u; if (!S.next(ui, u)) break;
        const char* gA = (const char*)A + (size_t)u.pm * 256 * lda; const char* gB = (const char*)B + (size_t)u.pn * 256 * ldb;
        f32x4 acc[8][4];
#pragma unroll
        for (int m = 0; m < 8; ++m)
#pragma unroll
            for (int n = 0; n < 4; ++n) acc[m][n] = (f32x4){0.f, 0.f, 0.f, 0.f};
        i32x8_t FA[4], FB[4];
        G8_BAR;
        G8_STAGE4(0, 0);
#define G8W_STEP(s, kt_) do { \
            G8_WAIT_V0; G8_BAR; G8_SCHED;                               \
            if ((kt_) + 1 < nt) G8_STAGE4(1 - (s), (kt_) + 1); \
            G8_LD4(FB, (s) * SS + boff); G8_LD4(FA, (s) * SS + aoff); G8_WAIT_L0; G8_SCHED; \
            G8_MMA4(0); G8_SCHED; \
            G8_LD4(FA, (s) * SS + aoff + 4 * 2048); G8_WAIT_L0; G8_SCHED; \
            G8_MMA4(1); G8_SCHED; } while (0)
        for (int kt = 0; kt < nt; kt += 2) { G8W_STEP(0, kt); G8W_STEP(1, kt + 1); }
#undef G8W_STEP
        E(acc, u.pm, u.pn, wr, wc, fr, fq);
    }
#undef G8_STAGE1
#undef G8_STAGE4
#undef G8_LD4
#undef G8_MMA4
#undef G8_WAIT_V0
#undef G8_WAIT_L0
#undef G8_BAR
#undef G8_SCHED
}
}
constexpr int NWAVES = 8;
constexpr int BATCH = 4, SEQ = 4096, D = 4096, M = BATCH * SEQ;
constexpr int DATTN = 2048, DPOOL = 2048, HD = 128, NH = 16, NPROJ = 3 * DATTN + DPOOL;
constexpr int NGRP = 4, PGRP = 512;
constexpr int MODW = 6 * D;
constexpr int PH = 8, PK = 16, NKEYS = 128, NEXP = NKEYS * NKEYS, PDQ = 256, PDH = 128, NQ = PH * PDQ;
constexpr float EPS = 1e-6f;
constexpr int NPHASE = 13;
constexpr int NSLU = 16;
constexpr int NSL = 32, SLB = 128;
#ifndef MK_N_LAUNCHES
#define MK_N_LAUNCHES 1
#endif
constexpr int N_LAUNCHES = MK_N_LAUNCHES;

constexpr size_t MiB = 1u << 20;
constexpr size_t WS_CTL = 0, CTL_ZERO_BYTES = 64 * 1024;
constexpr size_t WS_MOD = 1 * MiB;
constexpr size_t WS_SK = 2 * MiB;
constexpr size_t WS_WPT = 3 * MiB;
constexpr size_t WS_IDX = 8 * MiB, WS_GW = 16 * MiB;
constexpr int LDK = D + 128;
constexpr size_t WS_WQT = 32 * MiB, WS_WOUTT = 50 * MiB, WS_WINT = 84 * MiB;
constexpr size_t WS_H = 152 * MiB;
constexpr size_t WS_PROJ = 288 * MiB;
constexpr size_t WS_CAT = 544 * MiB;
constexpr size_t WS_DP = 678 * MiB;
constexpr int LDP = DPOOL + 128;
constexpr size_t WS_QP = 742 * MiB;
constexpr size_t WS_X1 = 806 * MiB;
constexpr size_t WS_CAT8 = 936 * MiB, WS_WMIX8 = 1000 * MiB, WS_SCA = 1016 * MiB, WS_SCB = 1017 * MiB;
constexpr size_t WS_U8 = 1056 * MiB, WS_V8 = 1120 * MiB;
constexpr size_t WS_SU = 1184 * MiB, WS_SV = 1185 * MiB;
constexpr size_t WS_H8 = 1186 * MiB;
constexpr size_t WS_SH = 1250 * MiB;
constexpr size_t WS_ACT = 1251 * MiB;
constexpr size_t WS_SSQ = 1259 * MiB;
constexpr size_t WS_PD = WS_PROJ;
constexpr size_t WS_Z = WS_CAT;
constexpr size_t WS_END = 1261 * MiB;
constexpr int CW_TMO = 0, CW_CODE = 1, CW_BAR = 4096;
constexpr int RING_OFF = 0, RING_BYTES = 131072;
constexpr int LDSCTL_OFF = RING_BYTES, MISC_OFF = LDSCTL_OFF + 320;
constexpr int LDS_BYTES = 147456;
static_assert(MISC_OFF + 128 <= LDS_BYTES, "LDS map");
#define GAS __attribute__((address_space(1)))
#define LAS __attribute__((address_space(3)))
typedef unsigned short bf16;
typedef unsigned v4u __attribute__((ext_vector_type(4)));
typedef float f32x4 __attribute__((ext_vector_type(4)));
typedef short bf16x8 __attribute__((ext_vector_type(8)));
typedef GAS unsigned gu32;
typedef GAS unsigned long long gu64;
#define RLX_AGENT __ATOMIC_RELAXED, __HIP_MEMORY_SCOPE_AGENT
#define LDS_WAIT() asm volatile("s_waitcnt lgkmcnt(0)" ::: "memory")
#define VM_WAIT() asm volatile("s_waitcnt vmcnt(0)" ::: "memory")
__device__ __forceinline__ unsigned long long rt() { return __builtin_amdgcn_s_memrealtime(); }
__device__ __forceinline__ unsigned f2bf(float f) { unsigned u = __builtin_bit_cast(unsigned, f); return (u + 0x7fffu + ((u >> 16) & 1u)) >> 16; }
__device__ __forceinline__ unsigned pk2(float lo, float hi) { return f2bf(lo) | (f2bf(hi) << 16); }

#define XB_TMO      128
#define XB_XCNT(j)  (256  + 64 * (j))
#define XB_XSUB(j)  (1280 + 64 * (j))
#define XB_XGEN(j)  (2304 + 64 * (j))
#define XB_TOP      3328
#define XB_TOPGEN   3392
#define XCD_BAR_WORDS 3456
#define XB_SPIN_CAP (1u << 18)

__device__ __forceinline__ unsigned xb_ld(unsigned* p)              { return __hip_atomic_load(p, __ATOMIC_RELAXED, __HIP_MEMORY_SCOPE_AGENT); }
__device__ __forceinline__ unsigned xb_add(unsigned* p, unsigned v) { return __hip_atomic_fetch_add(p, v, __ATOMIC_RELAXED, __HIP_MEMORY_SCOPE_AGENT); }
__device__ __forceinline__ unsigned xb_xcc_id() { return (unsigned)__builtin_amdgcn_s_getreg((3 << 11) | 20) & 0xFu; }
#define XB_SPIN(cond, bar) do { unsigned _sp = 0; while (cond) { __builtin_amdgcn_s_sleep(1); \
    if ((++_sp & 255u) == 0u) { if (xb_ld(&(bar)[XB_TMO])) break; if (_sp > XB_SPIN_CAP) { atomicAdd(&(bar)[XB_TMO], 1u); break; } } } } while (0)

struct XcdBarrier {
    unsigned* bar; unsigned x;
    volatile LAS unsigned* st;
};

__device__ __forceinline__ XcdBarrier xcd_barrier_post(unsigned* bar, volatile LAS unsigned* st) {
    XcdBarrier b; b.bar = bar; b.x = xb_xcc_id(); b.st = st;
    if (threadIdx.x == 0) (void)xb_add(&bar[XB_XCNT(b.x)], 1u);
    return b;
}
__device__ __forceinline__ void xcd_barrier_complete(unsigned* bar, unsigned x, unsigned& nloc, unsigned& nx) {
    const unsigned G = gridDim.x * gridDim.y * gridDim.z;
    unsigned sum, cnt, mine, sp = 0u;
    for (;;) {
        sum = 0u; cnt = 0u; mine = 0u;
#pragma unroll
        for (unsigned j = 0; j < 16; ++j) { const unsigned c = xb_ld(&bar[XB_XCNT(j)]); sum += c; cnt += (c > 0u) ? 1u : 0u; mine = (j == x) ? c : mine; }
        if (sum == G) break;
        __builtin_amdgcn_s_sleep(1);
        if ((++sp & 255u) == 0u) { if (xb_ld(&bar[XB_TMO])) break; if (sp > XB_SPIN_CAP) { atomicAdd(&bar[XB_TMO], 1u); break; } }
    }
    nloc = mine > 0u ? mine : 1u; nx = cnt > 0u ? cnt : 1u;
}

__device__ __forceinline__ void xcd_barrier(const XcdBarrier& b) {
    asm volatile("s_waitcnt vmcnt(0)" ::: "memory");
    __syncthreads();
    if (threadIdx.x == 0) {
        unsigned* bar = b.bar;
        __builtin_amdgcn_s_waitcnt(0);
        unsigned nloc = b.st[0], nx = b.st[1];
        if (nloc == 0u) { xcd_barrier_complete(bar, b.x, nloc, nx); b.st[0] = nloc; b.st[1] = nx; }
        const unsigned old = xb_add(&bar[XB_XSUB(b.x)], 1u);
        const unsigned gen = old / nloc;
        if (old + 1u == (gen + 1u) * nloc) {
            __builtin_amdgcn_fence(__ATOMIC_RELEASE, "agent");
            asm volatile("s_waitcnt vmcnt(0)" ::: "memory");
            const unsigned og = xb_add(&bar[XB_TOP], 1u);
            const unsigned tg = og / nx;
            if (og + 1u == (tg + 1u) * nx) xb_add(&bar[XB_TOPGEN], 1u);
            else XB_SPIN(xb_ld(&bar[XB_TOPGEN]) == tg, bar);
            __builtin_amdgcn_fence(__ATOMIC_ACQUIRE, "agent");
            xb_add(&bar[XB_XGEN(b.x)], 1u);
            asm volatile("s_waitcnt vmcnt(0)" ::: "memory");
        } else {
            XB_SPIN(xb_ld(&bar[XB_XGEN(b.x)]) == gen, bar);
            __builtin_amdgcn_fence(__ATOMIC_ACQUIRE, "agent");
            asm volatile("s_waitcnt vmcnt(0)" ::: "memory");
        }
    }
    __syncthreads();
}
typedef float f32x16 __attribute__((ext_vector_type(16)));
typedef short s16x4 __attribute__((ext_vector_type(4)));
typedef __bf16 bf16v2 __attribute__((ext_vector_type(2)));
typedef float f32x2 __attribute__((ext_vector_type(2)));
typedef int i32x2 __attribute__((ext_vector_type(2)));
#define DI __device__ __forceinline__
#define MFMA32(a, b, c) __builtin_amdgcn_mfma_f32_32x32x16_bf16((a), (b), (c), 0, 0, 0)
DI unsigned pkbf(float lo, float hi) { bf16v2 v = {(__bf16)lo, (__bf16)hi}; return __builtin_bit_cast(unsigned, v); }
DI float bflo(unsigned u) { return __builtin_bit_cast(float, u << 16); }
DI float bfhi(unsigned u) { return __builtin_bit_cast(float, u & 0xffff0000u); }
constexpr float FP4_K2 = 6.f;
constexpr float FP4_TOP = 6.f;
constexpr float FP4_CLIP = 0.8f;
constexpr float CAT_SCALE = 32.f;
DI unsigned pk4_fp8(float a, float b, float c, float d) {
    const float lim = 448.f;
    a = fminf(fmaxf(a * CAT_SCALE, -lim), lim); b = fminf(fmaxf(b * CAT_SCALE, -lim), lim); c = fminf(fmaxf(c * CAT_SCALE, -lim), lim); d = fminf(fmaxf(d * CAT_SCALE, -lim), lim);
    int pk = __builtin_amdgcn_cvt_pk_fp8_f32(a, b, 0, false); pk = __builtin_amdgcn_cvt_pk_fp8_f32(c, d, pk, true); return (unsigned)pk;
}
DI int crow(int reg, int h) { return (reg & 3) + 8 * (reg >> 2) + 4 * h; }
DI float wave_sum(float v) {
#pragma unroll
    for (int o = 1; o < 64; o <<= 1) v += __shfl_xor(v, o);
    return v;
}
struct Frame {
    LAS unsigned char* lds;
    volatile LAS unsigned* MISC;
    gu32* ctl;
    int tid, lane, wave, vcu, G;
    const float *x, *c, *w_ada, *b_ada, *g1, *w_in, *g_ah, *w_pool, *s_pool, *w_out, *g2, *w_query, *sk1, *sk2, *u_exp, *v_exp, *g_final;
    float* out;
    float* MOD; bf16 *SK, *WPS, *WQT, *WMIXT, *WOP, *WINT, *H, *PROJ, *CAT, *QP, *DELTA; unsigned short* IDX; float* GW;
    unsigned char *U8, *V8, *H8, *ACT8, *CAT8, *WMIX8; float *SCA, *SCB; float *SU, *SV, *SH, *SA, *SSQ; bf16 *PD, *Z;
};

DI void p0_transpose_item(const float* W, int K, int N, bf16* WT, int ldt, int row_off, LAS float* scr, int item, int lane) {
    const int nblk = N / 32, kb = item / nblk, nb = item % nblk, k0 = 64 * kb, n0 = 32 * nb;
    float tv[32];
#pragma unroll
    for (int i = 0; i < 32; ++i) tv[i] = W[(size_t)(k0 + 2 * i + (lane >> 5)) * N + n0 + (lane & 31)];
#pragma unroll
    for (int i = 0; i < 32; ++i) scr[(2 * i + (lane >> 5)) * 33 + (lane & 31)] = tv[i];
    LDS_WAIT(); asm volatile("" ::: "memory");
    const int c = lane & 7;
#pragma unroll
    for (int j = 0; j < 4; ++j) { const int n = (lane >> 3) + 8 * j; const LAS float* s = scr + (8 * c) * 33 + n;
        v4u o; o.x = pkbf(s[0 * 33], s[1 * 33]); o.y = pkbf(s[2 * 33], s[3 * 33]); o.z = pkbf(s[4 * 33], s[5 * 33]); o.w = pkbf(s[6 * 33], s[7 * 33]);
        *(GAS v4u*)(WT + (size_t)(row_off + n0 + n) * ldt + k0 + 8 * c) = o; }
    LDS_WAIT(); asm volatile("" ::: "memory");
}
DI void conv_row_fp8(const float* src, unsigned char* tab, int e, float* scale_out, int lane) {
    const GAS f32x4* p = (const GAS f32x4*)src + lane;
    f32x4 v[16]; float am = 0.f;
#pragma unroll
    for (int j = 0; j < 16; ++j) { v[j] = p[64 * j]; am = fmaxf(fmaxf(am, fmaxf(__builtin_fabsf(v[j].x), __builtin_fabsf(v[j].y))), fmaxf(__builtin_fabsf(v[j].z), __builtin_fabsf(v[j].w))); }
#pragma unroll
    for (int o = 1; o < 64; o <<= 1) am = fmaxf(am, __shfl_xor(am, o));
    const float sc = am > 1e-30f ? am * (1.f / 448.f) : 1.f, inv = am > 1e-30f ? 448.f / am : 0.f;
#pragma unroll
    for (int j = 0; j < 16; ++j) { int pk = __builtin_amdgcn_cvt_pk_fp8_f32(v[j].x * inv, v[j].y * inv, 0, false); pk = __builtin_amdgcn_cvt_pk_fp8_f32(v[j].z * inv, v[j].w * inv, pk, true);
        *(GAS unsigned*)(tab + ((size_t)(2 * j + (lane >> 5)) * NEXP + e) * SLB + 4 * (lane & 31)) = (unsigned)pk; }
    if (lane == 0) *scale_out = sc;
}
DI unsigned fp4_code(float x) {
    const float m = __builtin_fabsf(x);
    const unsigned c = (unsigned)(m >= 0.25f) + (unsigned)(m >= 0.75f) + (unsigned)(m >= 1.25f) + (unsigned)(m >= 1.75f) + (unsigned)(m >= 2.5f) + (unsigned)(m >= 3.5f) + (unsigned)(m >= 5.0f);
    return c | (x < 0.f ? 8u : 0u);
}
DI float fp4_val(unsigned c) {
    const unsigned e = (c >> 1) & 3u, mbit = c & 1u;
    const float mag = e == 0u ? 0.5f * (float)mbit : (float)(1u << (e - 1u)) * (1.f + 0.5f * (float)mbit);
    return (c & 8u) ? -mag : mag;
}
DI unsigned fp4_pack4(float a, float b, float c, float d) { unsigned r = 0; r = __builtin_amdgcn_cvt_scalef32_pk_fp4_f32(r, a, b, 1.0f, 0); r = __builtin_amdgcn_cvt_scalef32_pk_fp4_f32(r, c, d, 1.0f, 1); return r; }
DI void fp4_planes4(float e0, float e1, float e2, float e3, unsigned& p0, unsigned& p1) {
    p0 = fp4_pack4(e0, e1, e2, e3);
    const f32x2 va = __builtin_amdgcn_cvt_scalef32_pk_f32_fp4(p0, 1.0f, 0), vb = __builtin_amdgcn_cvt_scalef32_pk_f32_fp4(p0, 1.0f, 1);
    p1 = fp4_pack4((e0 - va.x) * FP4_K2, (e1 - va.y) * FP4_K2, (e2 - vb.x) * FP4_K2, (e3 - vb.y) * FP4_K2);
}
DI void conv_row_fp4(const float* src, unsigned char* tab, int e, float* scale_out, int lane) {
    const GAS f32x4* p = (const GAS f32x4*)src + lane;
    f32x4 v[16]; float am = 0.f;
#pragma unroll
    for (int j = 0; j < 16; ++j) { v[j] = p[64 * j]; am = fmaxf(fmaxf(am, fmaxf(__builtin_fabsf(v[j].x), __builtin_fabsf(v[j].y))), fmaxf(__builtin_fabsf(v[j].z), __builtin_fabsf(v[j].w))); }
#pragma unroll
    for (int o = 1; o < 64; o <<= 1) am = fmaxf(am, __shfl_xor(am, o));
    const float sc = am > 1e-30f ? am * (FP4_CLIP / FP4_TOP) : 1.f, inv = am > 1e-30f ? FP4_TOP / (FP4_CLIP * am) : 0.f;
#pragma unroll
    for (int j = 0; j < 16; ++j) {
        const unsigned pk = fp4_pack4(v[j].x * inv, v[j].y * inv, v[j].z * inv, v[j].w * inv);
        *(GAS unsigned short*)(tab + ((size_t)j * NEXP + e) * SLB + 2 * lane) = (unsigned short)pk; }
    if (lane == 0) *scale_out = sc;
}
DI void ph0_prologue(Frame& F) {
    LAS float* sc = (LAS float*)(F.lds + RING_OFF);
    LAS float* red = (LAS float*)(F.lds + RING_OFF + 65536);
    for (int i = F.tid; i < BATCH * D; i += NWAVES * 64) { const float cv = F.c[i]; sc[i] = cv / (1.f + __expf(-cv)); }
    __syncthreads();
    const int cq = F.tid % 24, rl = F.tid / 24;
#ifdef PROBE_P0A
    for (int rep_ = 0; rep_ < 2; ++rep_)
#endif
    for (int cc = F.vcu; cc < MODW / 96; cc += F.G) {
        if (rl < 21) {
            f32x4 a0 = {0.f, 0.f, 0.f, 0.f}, a1 = a0, a2 = a0, a3 = a0;
            const float* wp = F.w_ada + (size_t)rl * MODW + 96 * cc + 4 * cq;
#pragma unroll 13
            for (int d = rl; d < D; d += 21) { const f32x4 w = *(const GAS f32x4*)wp; wp += (size_t)21 * MODW;
                a0 += sc[d] * w; a1 += sc[D + d] * w; a2 += sc[2 * D + d] * w; a3 += sc[3 * D + d] * w; }
            LAS f32x4* rp = (LAS f32x4*)(red + (rl * 24 + cq) * 16); rp[0] = a0; rp[1] = a1; rp[2] = a2; rp[3] = a3;
        }
        __syncthreads();
        if (F.tid < 384) { const int q = F.tid >> 4, e = F.tid & 15; float s = 0.f;
            for (int r2 = 0; r2 < 21; ++r2) s += red[(r2 * 24 + q) * 16 + e];
            const int col = 96 * cc + 4 * q + (e & 3); F.MOD[(e >> 2) * MODW + col] = s + F.b_ada[col]; }
        __syncthreads();
    }
    LAS float* scr = (LAS float*)(F.lds + RING_OFF + F.wave * 16384);
    const int gw = F.vcu * NWAVES + F.wave, NGW = F.G * NWAVES;
    constexpr int I_IN = (D / 64) * (NPROJ / 32), I_OUT = (D / 64) * (D / 32), I_Q = (D / 64) * (NQ / 32), I_P1 = (PGRP / 64) * (PGRP / 32);
    constexpr int NITEMS = I_IN + I_OUT + I_Q;
#ifdef PROBE_P0B
    for (int rep_ = 0; rep_ < 2; ++rep_)
#endif
    for (int it = gw; it < NITEMS; it += NGW) {
        int r = it;
        if (r < I_IN) { p0_transpose_item(F.w_in, D, NPROJ, F.WINT, LDK, 0, scr, r, F.lane); continue; } r -= I_IN;
        if (r < I_OUT) { const int kb = r / (D / 32);
            if (kb < DATTN / 64) p0_transpose_item(F.w_out, D, D, F.WMIXT, LDK, 0, scr, r, F.lane); else p0_transpose_item(F.w_out, D, D, F.WOP - DATTN, LDP, 0, scr, r, F.lane);
            continue; } r -= I_OUT;
        if (r < I_Q) { p0_transpose_item(F.w_query, D, NQ, F.WQT, LDK, 0, scr, r, F.lane); continue; } r -= I_Q;
    }
    for (int i = F.vcu * NWAVES * 64 + F.tid; i < NGRP * PGRP * PGRP / 4; i += F.G * NWAVES * 64) {
        const f32x4 w = ((const GAS f32x4*)F.w_pool)[i]; const int e0 = 4 * i, g = e0 / (PGRP * PGRP), d0 = e0 % PGRP;
        const f32x4 sp = *(const GAS f32x4*)(F.s_pool + g * PGRP + d0);
        ((GAS unsigned long long*)F.WPS)[i] = (unsigned long long)pkbf(w.x * sp.x, w.y * sp.y) | ((unsigned long long)pkbf(w.z * sp.z, w.w * sp.w) << 32);
    }
#ifdef PROBE_P0D
    for (int rep_ = 0; rep_ < 2; ++rep_)
#endif
    for (int row = gw; row < 2 * NEXP; row += NGW) {
        if (row < NEXP) conv_row_fp4(F.u_exp + (size_t)row * D, F.U8, row, F.SU + row, F.lane);
        else { const int e = row - NEXP; conv_row_fp4(F.v_exp + (size_t)e * D, F.V8, e, F.SV + e, F.lane); }
    }
    for (int i = F.vcu * NWAVES * 64 + F.tid; i < NKEYS * PDH; i += F.G * NWAVES * 64) {
        const float* src = (i < NKEYS * PDH / 2) ? F.sk1 + 2 * i : F.sk2 + 2 * (i - NKEYS * PDH / 2);
        ((GAS unsigned*)F.SK)[i] = pkbf(src[0], src[1]);
    }
}

template <bool FP8> DI void norm_phase(Frame& F, const float* src, const float* gain, int kshift, int kscale, bf16* dst) {
    LAS float* A1 = (LAS float*)(F.lds + RING_OFF);
    LAS float* S1 = A1 + D;
    for (int rt = F.vcu; rt < M / 64; rt += F.G) {
        const int b = (rt * 64) / SEQ;
        __syncthreads();
        for (int i = F.tid; i < D; i += NWAVES * 64) { A1[i] = gain[i] * (1.f + F.MOD[b * MODW + kscale * D + i]); S1[i] = F.MOD[b * MODW + kshift * D + i]; }
        __syncthreads();
        for (int i = 0; i < 8; ++i) {
            const int m = rt * 64 + F.wave * 8 + i;
            f32x4 v[16]; float ss = 0.f;
            if (!FP8) { const GAS f32x4* xr = (const GAS f32x4*)(src + (size_t)m * D) + F.lane;
#pragma unroll
                for (int j = 0; j < 16; ++j) v[j] = xr[64 * j];
            } else {
                const GAS unsigned long long* dr = (const GAS unsigned long long*)(F.DELTA + (size_t)m * D) + F.lane;
#pragma unroll
                for (int j = 0; j < 16; ++j) { const unsigned long long q = dr[64 * j]; const unsigned lo = (unsigned)q, hi = (unsigned)(q >> 32);
                    v[j].x = bflo(lo); v[j].y = bfhi(lo); v[j].z = bflo(hi); v[j].w = bfhi(hi); }
            }
#pragma unroll
            for (int j = 0; j < 16; ++j) ss += (v[j].x * v[j].x + v[j].y * v[j].y) + (v[j].z * v[j].z + v[j].w * v[j].w);
            const float rstd = 1.f / sqrtf(wave_sum(ss) * (1.f / D) + EPS);
            GAS unsigned long long* o8 = (GAS unsigned long long*)(dst + (size_t)m * LDK) + F.lane;
#pragma unroll
            for (int j = 0; j < 16; ++j) { const f32x4 a = *(const LAS f32x4*)(A1 + 4 * F.lane + 256 * j), s = *(const LAS f32x4*)(S1 + 4 * F.lane + 256 * j);
                const f32x4 o = v[j] * rstd * a + s; v[j] = o;
                o8[64 * j] = (unsigned long long)pkbf(o.x, o.y) | ((unsigned long long)pkbf(o.z, o.w) << 32); }
            if (FP8) {
                float am = 0.f;
#pragma unroll
                for (int j = 0; j < 16; ++j) am = fmaxf(fmaxf(am, fmaxf(__builtin_fabsf(v[j].x), __builtin_fabsf(v[j].y))), fmaxf(__builtin_fabsf(v[j].z), __builtin_fabsf(v[j].w)));
#pragma unroll
                for (int o = 1; o < 64; o <<= 1) am = fmaxf(am, __shfl_xor(am, o));
                const float sc = am > 1e-30f ? am * (1.f / FP4_TOP) : 1.f, inv = am > 1e-30f ? FP4_TOP / am : 0.f;
                GAS unsigned char* d4 = (GAS unsigned char*)(F.H8 + (size_t)m * D);
#pragma unroll
                for (int j = 0; j < 16; ++j) { const float e0 = v[j].x * inv, e1 = v[j].y * inv, e2 = v[j].z * inv, e3 = v[j].w * inv;
                    unsigned q0, q1; fp4_planes4(e0, e1, e2, e3, q0, q1);
                    *(GAS unsigned short*)(d4 + 128 * j + 2 * F.lane) = (unsigned short)q0;
                    *(GAS unsigned short*)(d4 + 2048 + 128 * j + 2 * F.lane) = (unsigned short)q1; }
                if (F.lane == 0) F.SH[m] = sc;
            }
        }
    }
}

template <int G> DI void pool_diff_group(Frame& F) {
    constexpr int W = 2 << G, NR = W + 3;
    const int gt = F.vcu * NWAVES * 64 + F.tid, NT = F.G * NWAVES * 64;
    for (int it = gt; it < (M / 4) * (PGRP / 8); it += NT) {
        const int m0 = (it >> 6) * 4, ci = it & 63, pos0 = m0 & (SEQ - 1);
        const bf16* p = F.PROJ + (size_t)3 * M * DATTN + (size_t)m0 * DPOOL + G * PGRP + ci * 8;
        v4u v[NR];
#pragma unroll
        for (int k = 0; k < NR; ++k) { const int back = (W - 1) - k; v[k] = *(const GAS v4u*)(p - (ptrdiff_t)((back > 0 && back <= pos0) ? back : (back > 0 ? 0 : back)) * DPOOL); }
        float s[8];
#pragma unroll
        for (int q = 0; q < 8; ++q) s[q] = 0.f;
#pragma unroll
        for (int k = 0; k < W; ++k) { const float wg = ((W - 1) - k <= pos0) ? 1.f : 0.f;
            s[0] += wg * bflo(v[k].x); s[1] += wg * bfhi(v[k].x); s[2] += wg * bflo(v[k].y); s[3] += wg * bfhi(v[k].y); s[4] += wg * bflo(v[k].z); s[5] += wg * bfhi(v[k].z); s[6] += wg * bflo(v[k].w); s[7] += wg * bfhi(v[k].w); }
#pragma unroll
        for (int j = 0; j < 4; ++j) {
            if (j > 0) { const float wo = ((W - 1) - (j - 1) <= pos0) ? 1.f : 0.f;
                const v4u a = v[j + W - 1], d = v[j - 1];
                s[0] += bflo(a.x) - wo * bflo(d.x); s[1] += bfhi(a.x) - wo * bfhi(d.x); s[2] += bflo(a.y) - wo * bflo(d.y); s[3] += bfhi(a.y) - wo * bfhi(d.y);
                s[4] += bflo(a.z) - wo * bflo(d.z); s[5] += bfhi(a.z) - wo * bfhi(d.z); s[6] += bflo(a.w) - wo * bflo(d.w); s[7] += bfhi(a.w) - wo * bfhi(d.w); }
            const int cnt = (pos0 + j + 1 < W) ? pos0 + j + 1 : W; const float inv = 1.f / (float)cnt; const v4u cur = v[j + W - 1];
            const unsigned o0 = pk4_fp8(s[0] * inv - bflo(cur.x), s[1] * inv - bfhi(cur.x), s[2] * inv - bflo(cur.y), s[3] * inv - bfhi(cur.y));
            const unsigned o1 = pk4_fp8(s[4] * inv - bflo(cur.z), s[5] * inv - bfhi(cur.z), s[6] * inv - bflo(cur.w), s[7] * inv - bfhi(cur.w));
            *(GAS unsigned long long*)(F.CAT8 + (size_t)(m0 + j) * D + DATTN + G * PGRP + ci * 8) = (unsigned long long)o0 | ((unsigned long long)o1 << 32);
        }
    }
}
DI void pool_diff_phase(Frame& F) { pool_diff_group<0>(F); pool_diff_group<1>(F); pool_diff_group<2>(F); pool_diff_group<3>(F); }

DI void conv_bf16_row_fp8(const bf16* src, unsigned char* dst, float* scale_out, int lane) {
    const GAS unsigned long long* p = (const GAS unsigned long long*)src + lane;
    f32x4 v[16]; float am = 0.f;
#pragma unroll
    for (int j = 0; j < 16; ++j) { const unsigned long long q = p[64 * j]; const unsigned lo = (unsigned)q, hi = (unsigned)(q >> 32);
        v[j].x = bflo(lo); v[j].y = bfhi(lo); v[j].z = bflo(hi); v[j].w = bfhi(hi);
        am = fmaxf(fmaxf(am, fmaxf(__builtin_fabsf(v[j].x), __builtin_fabsf(v[j].y))), fmaxf(__builtin_fabsf(v[j].z), __builtin_fabsf(v[j].w))); }
#pragma unroll
    for (int o = 1; o < 64; o <<= 1) am = fmaxf(am, __shfl_xor(am, o));
    const float sc = am > 1e-30f ? am * (1.f / 448.f) : 1.f, inv = am > 1e-30f ? 448.f / am : 0.f;
    GAS unsigned* d = (GAS unsigned*)dst + lane;
#pragma unroll
    for (int j = 0; j < 16; ++j) { int pk = __builtin_amdgcn_cvt_pk_fp8_f32(v[j].x * inv, v[j].y * inv, 0, false); pk = __builtin_amdgcn_cvt_pk_fp8_f32(v[j].z * inv, v[j].w * inv, pk, true); d[64 * j] = (unsigned)pk; }
    if (lane == 0) *scale_out = sc;
}
DI void mix_weight_fp8(Frame& F) {
    const int gw = F.vcu * NWAVES + F.wave, NGW = F.G * NWAVES;
    for (int n = gw; n < D; n += NGW) { int ln = F.lane; asm volatile("" : "+v"(ln)); conv_bf16_row_fp8(F.WMIXT + (size_t)n * LDK, F.WMIX8 + (size_t)n * D, F.SCB + n, ln); }
}

constexpr int KT_OFF = 0, VT_OFF = 8192;
DI void attn_dma_tile(LAS unsigned char* dst, const bf16* src, const unsigned (&dv)[4]) {
#pragma unroll
    for (int i = 0; i < 8; ++i)
        __builtin_amdgcn_global_load_lds((const unsigned*)((const char*)src + dv[i & 3] + i * 1024), (LAS unsigned*)(dst + i * 1024), 16, 0, 0);
}
template <bool DIAG> DI void attn_block(LAS unsigned char* wl, const bf16* knext, const bf16* vnext, const unsigned (&dv)[4], const bf16x8 (&qf)[8], f32x16 (&o)[4], float& R, int lane, int r, int hh, unsigned trE, unsigned trO) {
    const float SC = 0.08838834764831845f * 1.4426950408889634f;
    asm volatile("s_waitcnt vmcnt(8)" ::: "memory");
    bf16x8 kf[8];
#pragma unroll
    for (int ks = 0; ks < 8; ++ks) kf[ks] = *(const LAS bf16x8*)(wl + KT_OFF + r * 256 + (((2 * ks + hh) ^ (r & 15)) << 4));
    asm volatile("s_waitcnt lgkmcnt(0)" ::: "memory");
    __builtin_amdgcn_sched_barrier(0);
    attn_dma_tile(wl + KT_OFF, knext, dv);
    __builtin_amdgcn_sched_barrier(0);
    f32x16 s;
#pragma unroll
    for (int i = 0; i < 16; ++i) s[i] = 0.f;
#pragma unroll
    for (int ks = 0; ks < 8; ++ks) s = MFMA32(kf[ks], qf[ks], s);
    float zz[16], sp[16], ln[16];
#pragma unroll
    for (int i = 0; i < 16; ++i) {
        zz[i] = s[i] * SC;
        const float e = __builtin_amdgcn_exp2f(-__builtin_fabsf(zz[i]));
        sp[i] = fmaxf(zz[i], 0.f) + __builtin_amdgcn_logf(1.f + e);
        const bool valid = !DIAG || (crow(i, hh) < r);
        ln[i] = valid ? -sp[i] : 0.f;
    }
    float Gs[4], Ps[4];
#pragma unroll
    for (int g = 0; g < 4; ++g) Gs[g] = (ln[4 * g] + ln[4 * g + 1]) + (ln[4 * g + 2] + ln[4 * g + 3]);
#pragma unroll
    for (int g = 0; g < 4; ++g) Ps[g] = __shfl_xor(Gs[g], 32);
    float later[4];
    later[3] = 0.f; later[2] = Gs[3] + Ps[3]; later[1] = later[2] + (Gs[2] + Ps[2]); later[0] = later[1] + (Gs[1] + Ps[1]);
    const float T = later[0] + (Gs[0] + Ps[0]);
    float a[16];
#pragma unroll
    for (int g = 0; g < 4; ++g) {
        const float bg = R + later[g] + ((hh == 0) ? Ps[g] : 0.f);
        const float w2 = ln[4 * g + 3], w1 = w2 + ln[4 * g + 2], w0 = w1 + ln[4 * g + 1];
        const float wv[4] = {w0, w1, w2, 0.f};
#pragma unroll
        for (int rr = 0; rr < 4; ++rr) { const int i = 4 * g + rr;
            const bool valid = !DIAG || (crow(i, hh) < r);
            const float ex = __builtin_amdgcn_exp2f((zz[i] - sp[i]) + (bg + wv[rr]));
            a[i] = valid ? ex : 0.f; }
    }
    R += T;
    v4u x0, x1;
    x0.x = pkbf(a[0], a[1]); x0.y = pkbf(a[2], a[3]); x0.z = pkbf(a[4], a[5]); x0.w = pkbf(a[6], a[7]);
    x1.x = pkbf(a[8], a[9]); x1.y = pkbf(a[10], a[11]); x1.z = pkbf(a[12], a[13]); x1.w = pkbf(a[14], a[15]);
    const bf16x8 xs0 = __builtin_bit_cast(bf16x8, x0), xs1 = __builtin_bit_cast(bf16x8, x1);
    asm volatile("s_waitcnt vmcnt(8)" ::: "memory");
    __builtin_amdgcn_sched_barrier(0);
#pragma unroll
    for (int c = 0; c < 4; ++c) {
        const unsigned ta = VT_OFF + ((c & 1) ? trO : trE) + 64 * (c & 1);
        const s16x4 l0 = __builtin_amdgcn_ds_read_tr16_b64_v4i16((LAS s16x4*)(wl + ta + 128 * (c >> 1)));
        const s16x4 h0 = __builtin_amdgcn_ds_read_tr16_b64_v4i16((LAS s16x4*)(wl + ta + 8 * 256 + 128 * ((c >> 1) ^ 1)));
        const s16x4 l1 = __builtin_amdgcn_ds_read_tr16_b64_v4i16((LAS s16x4*)(wl + ta + 16 * 256 + 128 * (c >> 1)));
        const s16x4 h1 = __builtin_amdgcn_ds_read_tr16_b64_v4i16((LAS s16x4*)(wl + ta + 24 * 256 + 128 * ((c >> 1) ^ 1)));
        const bf16x8 vf0 = __builtin_shufflevector(l0, h0, 0, 1, 2, 3, 4, 5, 6, 7), vf1 = __builtin_shufflevector(l1, h1, 0, 1, 2, 3, 4, 5, 6, 7);
        o[c] = MFMA32(vf0, xs0, o[c]);
        o[c] = MFMA32(vf1, xs1, o[c]);
    }
    asm volatile("s_waitcnt lgkmcnt(0)" ::: "memory");
    __builtin_amdgcn_sched_barrier(0);
    attn_dma_tile(wl + VT_OFF, vnext, dv);
    __builtin_amdgcn_sched_barrier(0);
}
DI void attn_task(Frame& F, LAS unsigned char* wl, int bh, int qt) {
    const int lane = F.lane, r = lane & 31, hh = lane >> 5;
    const int b = bh >> 4, h = bh & 15, t0 = 32 * qt;
    const bf16* qb = F.PROJ + (size_t)bh * SEQ * HD, *kb_ = qb + (size_t)M * DATTN, *vb = kb_ + (size_t)M * DATTN;
    bf16x8 qf[8];
    { const bf16* qp = qb + (size_t)(t0 + r) * HD + 8 * hh;
#pragma unroll
      for (int ks = 0; ks < 8; ++ks) qf[ks] = *(const GAS bf16x8*)(qp + 16 * ks); }
    unsigned dv[4];
    { const int q4 = lane >> 4, g0 = (lane & 15) ^ q4;
#pragma unroll
      for (int m = 0; m < 4; ++m) dv[m] = (unsigned)(q4 * 256 + 16 * (g0 ^ (4 * m))); }
    attn_dma_tile(wl + KT_OFF, kb_ + (size_t)t0 * HD, dv);
    attn_dma_tile(wl + VT_OFF, vb + (size_t)t0 * HD, dv);
    f32x16 o[4];
#pragma unroll
    for (int c = 0; c < 4; ++c)
#pragma unroll
        for (int i = 0; i < 16; ++i) o[c][i] = 0.f;
    float R = 0.f;
    const int L16 = lane & 15, trq = L16 >> 2, trp = L16 & 3, blk = (lane >> 4) & 1;
    const unsigned trb = (unsigned)((4 * hh + trq) * 256 + ((((2 * blk + (trp >> 1)) ^ trq)) << 4) + 8 * (trp & 1));
    const unsigned trE = trb + 64 * hh, trO = trb - 64 * hh;
    for (int kb = qt; kb >= 0; --kb) {
        const size_t sn = (size_t)32 * (kb > 0 ? kb - 1 : 0) * HD;
        if (kb == qt) attn_block<true>(wl, kb_ + sn, vb + sn, dv, qf, o, R, lane, r, hh, trE, trO);
        else attn_block<false>(wl, kb_ + sn, vb + sn, dv, qf, o, R, lane, r, hh, trE, trO);
        if (__all(R < -152.f)) break;
    }
    asm volatile("s_waitcnt vmcnt(0)" ::: "memory");
    float ss = 0.f;
#pragma unroll
    for (int c = 0; c < 4; ++c)
#pragma unroll
        for (int i = 0; i < 16; ++i) ss += o[c][i] * o[c][i];
    ss += __shfl_xor(ss, 32);
    const float rstd = 1.f / sqrtf(ss * (1.f / HD) + EPS);
    const float* gp = F.g_ah + h * HD;
    int lq = lane; asm volatile("" : "+v"(lq));
    const int rq = lq & 31, hq = lq >> 5;
    constexpr int OP = 144;
#pragma unroll
    for (int c = 0; c < 4; ++c)
#pragma unroll
        for (int g = 0; g < 4; ++g) { const int d0 = 32 * c + 8 * g + 4 * hq; const f32x4 gv = *(const GAS f32x4*)(gp + d0);
            *(LAS unsigned*)(wl + rq * OP + d0) = pk4_fp8(o[c][4 * g] * rstd * gv.x, o[c][4 * g + 1] * rstd * gv.y, o[c][4 * g + 2] * rstd * gv.z, o[c][4 * g + 3] * rstd * gv.w); }
    unsigned char* obase = F.CAT8 + (size_t)(b * SEQ + t0) * D + h * HD;
#pragma unroll
    for (int j = 0; j < 4; ++j) { const int row = 8 * j + (lq >> 3), ch = lq & 7;
        *(GAS v4u*)(obase + (size_t)row * D + 16 * ch) = *(const LAS v4u*)(wl + row * OP + 16 * ch); }
}
DI void attn_phase(Frame& F) {
    LAS unsigned char* wl = F.lds + RING_OFF + F.wave * 16384;
    const int gw = F.vcu * NWAVES + F.wave, NGW = F.G * NWAVES;
    for (int wt = gw; wt < BATCH * NH * (SEQ / 32); wt += NGW) attn_task(F, wl, wt >> 7, wt & 127);
}
DI int f2key(float f) { const int b = __builtin_bit_cast(int, f); return b ^ ((b >> 31) & 0x7fffffff); }
DI float key2f(int k) { const int b = k ^ ((k >> 31) & 0x7fffffff); return __builtin_bit_cast(float, b); }
DI void ce_desc(int& a, int& b) { const int hi = a > b ? a : b, lo = a > b ? b : a; a = hi; b = lo; }
DI int imax(int a, int b) { return a > b ? a : b; }
DI void sort16_desc(int (&v)[16]) {
#pragma unroll
    for (int k = 2; k <= 16; k <<= 1)
#pragma unroll
        for (int j = k >> 1; j > 0; j >>= 1)
#pragma unroll
            for (int i = 0; i < 16; ++i) { const int l = i ^ j; if (l > i) { if ((i & k) == 0) ce_desc(v[i], v[l]); else ce_desc(v[l], v[i]); } }
}
DI void bitonic_merge16_desc(int (&v)[16]) {
#pragma unroll
    for (int j = 8; j > 0; j >>= 1)
#pragma unroll
        for (int i = 0; i < 16; ++i) { const int l = i ^ j; if (l > i) ce_desc(v[i], v[l]); }
}
DI void merge_top16(int (&A)[16], const int (&B)[16]) {
#pragma unroll
    for (int i = 0; i < 16; ++i) A[i] = imax(A[i], B[15 - i]);
    bitonic_merge16_desc(A);
}
DI void route_scores(Frame& F, int tok, int hd, int half, int r, int hh, int (&tk)[16]) {
    bf16x8 qf[8];
    { const bf16* qp = F.QP + ((size_t)hd * M + tok) * PDQ + half * PDH + 8 * hh;
#pragma unroll
      for (int ks = 0; ks < 8; ++ks) qf[ks] = *(const GAS bf16x8*)(qp + 16 * ks); }
    int top[16];
#pragma unroll
    for (int c = 0; c < 4; ++c) {
        f32x16 s;
#pragma unroll
        for (int i = 0; i < 16; ++i) s[i] = 0.f;
        const bf16* kp = F.SK + (size_t)half * NKEYS * PDH + (size_t)(32 * c + r) * PDH + 8 * hh;
#pragma unroll
        for (int ks = 0; ks < 8; ++ks) { const bf16x8 kf = *(const GAS bf16x8*)(kp + 16 * ks); s = MFMA32(kf, qf[ks], s); }
        int kk[16];
#pragma unroll
        for (int i = 0; i < 16; ++i) kk[i] = (f2key(s[i]) & ~127) | (32 * c + (i & 3) + 8 * (i >> 2) + 4 * hh);
        sort16_desc(kk);
        if (c == 0) {
#pragma unroll
            for (int i = 0; i < 16; ++i) top[i] = kk[i];
        } else merge_top16(top, kk);
        __builtin_amdgcn_sched_barrier(0);
    }
    int pk[16];
#pragma unroll
    for (int i = 0; i < 16; ++i) pk[i] = __shfl_xor(top[i], 32);
    merge_top16(top, pk);
#pragma unroll
    for (int i = 0; i < 16; ++i) tk[i] = top[i];
}
struct CandTab { int a[50], b[50]; };
DI void route_task(Frame& F, LAS unsigned* wl, int tt, int hd) {
    const int lane = F.lane, r = lane & 31, hh = lane >> 5;
    const int tok = 32 * tt + r;
    int t1[16], t2[16];
    route_scores(F, tok, hd, 0, r, hh, t1);
    route_scores(F, tok, hd, 1, r, hh, t2);
    float v1[16], v2[16];
#pragma unroll
    for (int k = 0; k < 16; ++k) { wl[k * 64 + lane] = (unsigned)(t1[k] & 127); wl[(16 + k) * 64 + lane] = (unsigned)(t2[k] & 127);
        v1[k] = key2f(t1[k] & ~127); v2[k] = key2f(t2[k] & ~127); }
    int top[16];
#pragma unroll
    for (int bb = 0; bb < 16; ++bb) top[bb] = (f2key(v1[0] + v2[bb]) & ~255) | (15 - bb);
#pragma unroll
    for (int a = 1; a < 8; ++a) {
        int row[16];
#pragma unroll
        for (int bb = 0; bb < 16; ++bb) row[bb] = ((a + 1) * (bb + 1) <= 16) ? ((f2key(v1[a] + v2[bb]) & ~255) | (a << 4) | (15 - bb)) : (int)0x80000000;
        merge_top16(top, row);
    }
    { int row[16];
#pragma unroll
      for (int q = 0; q < 16; ++q) row[q] = (q < 8) ? ((f2key(v1[8 + q] + v2[0]) & ~255) | ((8 + q) << 4) | 15) : (int)0x80000000;
      merge_top16(top, row); }
    float fv[16]; int fe[16];
#pragma unroll
    for (int k = 0; k < 16; ++k) { const int a = (top[k] >> 4) & 15, bb = 15 - (top[k] & 15);
        fe[k] = (int)(wl[a * 64 + lane] * NKEYS + wl[(16 + bb) * 64 + lane]); fv[k] = key2f(top[k] & ~255); }
    float ev[16], sum = 0.f;
#pragma unroll
    for (int k = 0; k < 16; ++k) { ev[k] = __expf(fv[k] - fv[0]); sum += ev[k]; }
    const float inv = 1.f / sum;
    if (hh == 0) {
        GAS v4u* ip = (GAS v4u*)(F.IDX + (size_t)tok * (PH * PK) + hd * PK); GAS f32x4* gp = (GAS f32x4*)(F.GW + (size_t)tok * (PH * PK) + hd * PK);
#pragma unroll
        for (int q = 0; q < 2; ++q) { v4u iv; iv.x = (unsigned)fe[8 * q] | ((unsigned)fe[8 * q + 1] << 16); iv.y = (unsigned)fe[8 * q + 2] | ((unsigned)fe[8 * q + 3] << 16);
            iv.z = (unsigned)fe[8 * q + 4] | ((unsigned)fe[8 * q + 5] << 16); iv.w = (unsigned)fe[8 * q + 6] | ((unsigned)fe[8 * q + 7] << 16); ip[q] = iv; }
#pragma unroll
        for (int q = 0; q < 4; ++q) {
            f32x4 gv; gv.x = ev[4 * q] * inv; gv.y = ev[4 * q + 1] * inv; gv.z = ev[4 * q + 2] * inv; gv.w = ev[4 * q + 3] * inv; gp[q] = gv; }
    }
}
DI void route_phase(Frame& F) {
    LAS unsigned* wl = (LAS unsigned*)(F.lds + RING_OFF + F.wave * 16384);
    const int gw = F.vcu * NWAVES + F.wave, NGW = F.G * NWAVES;
    for (int wt = gw; wt < (M / 32) * PH; wt += NGW) route_task(F, wl, wt >> 3, wt & 7);
}

DI float gelu_erf(float v) { return 0.5f * v * (1.f + erff(v * 0.70710678118654752f)); }
DI void slice_partition(Frame& F, int& x, int& sstep, int& t_lo, int& t_hi) {
    int rank, nrank;
    if ((F.G & 7) == 0) { x = blockIdx.x & 7; rank = blockIdx.x >> 3; nrank = F.G >> 3; sstep = 8; } else { x = 0; rank = blockIdx.x; nrank = F.G; sstep = 1; }
    t_lo = (int)((long)M * rank / nrank); t_hi = (int)((long)M * (rank + 1) / nrank);
}
DI long mk64(unsigned lo, unsigned hi) { return (long)(((unsigned long long)hi << 32) | lo); }
#ifndef GATHER_AUX
#define GATHER_AUX 0
#endif
DI __amdgpu_buffer_rsrc_t slice_rsrc(const unsigned char* base) { return __builtin_amdgcn_make_buffer_rsrc((void*)base, 0, NEXP * SLB, 0x00020000); }
struct UTok { v4u g[16]; v4u h[2][2]; };
DI void u_idx(Frame& F, int t, int gq, v4u (&ei)[2]) {
#pragma unroll
    for (int q = 0; q < 2; ++q) ei[q] = *(const GAS v4u*)(F.IDX + (size_t)t * 128 + 16 * gq + 8 * q);
}
DI unsigned id_of(const v4u (&ei)[2], int i) { const unsigned w = ei[i >> 3][(i >> 1) & 3]; return (i & 1) ? (w >> 16) : (w & 0xffffu); }
DI void u_load(Frame& F, __amdgpu_buffer_rsrc_t rs, unsigned suboff, int s, int kg, int t, const v4u (&ei)[2], UTok& T) {
#pragma unroll
    for (int i = 0; i < 16; ++i) T.g[i] = __builtin_amdgcn_raw_buffer_load_b128(rs, id_of(ei, i) * SLB + suboff, 0, GATHER_AUX);
#pragma unroll
    for (int st = 0; st < 2; ++st) { const GAS unsigned char* hp = (const GAS unsigned char*)(F.H8 + (size_t)t * D + 128 * s + 64 * st + 16 * kg); T.h[st][0] = *(const GAS v4u*)hp; T.h[st][1] = *(const GAS v4u*)(hp + 2048); }
}
DI void tile_stage(LAS unsigned char* wl, int lane, const v4u (&g)[16]) {
    const int gq = lane >> 3, sub = lane & 7;
#pragma unroll
    for (int i = 0; i < 16; ++i) *(LAS v4u*)(wl + (16 * gq + i) * SLB + ((sub ^ ((i >> 1) & 7)) << 4)) = g[i];
}
typedef int i32x8v __attribute__((ext_vector_type(8)));
DI void u_mfma_store(Frame& F, LAS unsigned char* wl, int s, int t, int lane, const v4u (&h)[2][2]) {
    const int n16 = lane & 15, kg = lane >> 4;
    const LAS unsigned char* rb = wl + n16 * SLB;
    const int sw = (n16 >> 1) & 7;
    float d[8];
#pragma unroll
    for (int hd = 0; hd < 8; ++hd) { f32x4 acc0 = {0.f, 0.f, 0.f, 0.f}, acc1 = acc0;
#pragma unroll
        for (int st = 0; st < 2; ++st) { const v4u bq = *(const LAS v4u*)(rb + hd * 16 * SLB + (((4 * st + kg) ^ sw) << 4));
            const i32x8v bb = (i32x8v){(int)bq.x, (int)bq.y, (int)bq.z, (int)bq.w, 0, 0, 0, 0};
            const i32x8v a0 = (i32x8v){(int)h[st][0].x, (int)h[st][0].y, (int)h[st][0].z, (int)h[st][0].w, 0, 0, 0, 0}, a1 = (i32x8v){(int)h[st][1].x, (int)h[st][1].y, (int)h[st][1].z, (int)h[st][1].w, 0, 0, 0, 0};
            acc0 = __builtin_amdgcn_mfma_scale_f32_16x16x128_f8f6f4(a0, bb, acc0, 4  , 4  , 0, 0, 0, 0);
            acc1 = __builtin_amdgcn_mfma_scale_f32_16x16x128_f8f6f4(a1, bb, acc1, 4, 4, 0, 0, 0, 0); }
        d[hd] = acc0[0] + acc1[0] * (1.f / FP4_K2); }
    const float da = kg == 0 ? d[0] : kg == 1 ? d[2] : kg == 2 ? d[4] : d[6], db = kg == 0 ? d[1] : kg == 1 ? d[3] : kg == 2 ? d[5] : d[7];
    LAS float* tw = (LAS float*)wl;
    tw[32 * kg + n16] = da; tw[32 * kg + 16 + n16] = db;
    { const f32x2 pv = *(const LAS f32x2*)(tw + 2 * lane); *(GAS unsigned*)(F.PD + ((size_t)s * M + t) * 128 + 2 * lane) = pkbf(pv.x, pv.y); }
}
DI void peer_u_phase(Frame& F) {
    const int lane = F.lane, gq = lane >> 3, sub = lane & 7, kg = lane >> 4;
    LAS unsigned char* wl = F.lds + RING_OFF + F.wave * 16384;
    int x, sstep, t_lo, t_hi; slice_partition(F, x, sstep, t_lo, t_hi);
    for (int s = x; s < NSLU; s += sstep) {
        const __amdgpu_buffer_rsrc_t ubase = slice_rsrc(F.U8 + (size_t)s * NEXP * SLB); const unsigned suboff = 16u * (unsigned)sub;
        const int t0 = t_lo + F.wave;
        v4u en[2]; UTok T;
        { v4u e0[2]; u_idx(F, t0 < t_hi ? t0 : t_lo, gq, e0); u_load(F, ubase, suboff, s, kg, t0 < t_hi ? t0 : t_lo, e0, T); }
        u_idx(F, t0 + NWAVES < t_hi ? t0 + NWAVES : t_lo, gq, en);
        for (int t = t0; t < t_hi; t += NWAVES) {
            const int t1 = t + NWAVES < t_hi ? t + NWAVES : t_lo, t2 = t + 2 * NWAVES < t_hi ? t + 2 * NWAVES : t_lo;
            tile_stage(wl, lane, T.g);
            v4u hc[2][2];
#pragma unroll
            for (int st = 0; st < 2; ++st) { hc[st][0] = T.h[st][0]; hc[st][1] = T.h[st][1]; }
            u_load(F, ubase, suboff, s, kg, t1, en, T);
            u_idx(F, t2, gq, en);
            u_mfma_store(F, wl, s, t, lane, hc);
        }
    }
}
DI void peer_act_phase(Frame& F) {
    const int gt = F.vcu * NWAVES * 64 + F.tid, NT = F.G * NWAVES * 64;
    for (int it = gt; it < M * 32; it += NT) {
        const int t = it >> 5, j4 = (it & 31) * 4;
        const GAS unsigned long long* p = (const GAS unsigned long long*)(F.PD + (size_t)t * 128 + j4);
        f32x4 sum = {0.f, 0.f, 0.f, 0.f};
#pragma unroll
        for (int s = 0; s < NSLU; ++s) { const unsigned long long q = p[(size_t)s * M * 32]; const unsigned lo = (unsigned)q, hi = (unsigned)(q >> 32);
            sum.x += bflo(lo); sum.y += bfhi(lo); sum.z += bflo(hi); sum.w += bfhi(hi); }
        const float sh = F.SH[t];
        const unsigned long long ev = *(const GAS unsigned long long*)(F.IDX + (size_t)t * 128 + j4); const f32x4 gw = *(const GAS f32x4*)(F.GW + (size_t)t * 128 + j4);
        float a[4];
#pragma unroll
        for (int c = 0; c < 4; ++c) { const int e = (int)((ev >> (16 * c)) & 0xffffu); a[c] = gelu_erf(sum[c] * sh * F.SU[e]) * gw[c] * F.SV[e]; }
        float am = fmaxf(fmaxf(__builtin_fabsf(a[0]), __builtin_fabsf(a[1])), fmaxf(__builtin_fabsf(a[2]), __builtin_fabsf(a[3])));
#pragma unroll
        for (int o = 1; o < 32; o <<= 1) am = fmaxf(am, __shfl_xor(am, o));
        const float sc = am > 1e-30f ? am * (1.f / FP4_TOP) : 1.f, inv = am > 1e-30f ? FP4_TOP / am : 0.f;
        unsigned p0, p1; fp4_planes4(a[0] * inv, a[1] * inv, a[2] * inv, a[3] * inv, p0, p1);
        GAS unsigned char* ap = (GAS unsigned char*)(F.ACT8 + (size_t)t * 128) + (j4 >> 1);
        *(GAS unsigned short*)ap = (unsigned short)p0; *(GAS unsigned short*)(ap + 64) = (unsigned short)p1;
        if ((it & 31) == 0) F.SA[t] = sc;
    }
}
struct VTok { v4u g[16]; v4u a[2]; f32x4 gv; unsigned long long dl; float sa; };
DI void v_load(Frame& F, __amdgpu_buffer_rsrc_t rs, unsigned suboff, int s, int lane, int t, const v4u (&ei)[2], VTok& T) {
    const int kg = lane >> 4;
#pragma unroll
    for (int i = 0; i < 16; ++i) T.g[i] = __builtin_amdgcn_raw_buffer_load_b128(rs, id_of(ei, i) * SLB + suboff, 0, GATHER_AUX);
    { const int col = 256 * s + 4 * lane;
      T.gv = *(const GAS f32x4*)(F.MOD + (size_t)(t / SEQ) * MODW + 5 * D + col);
      T.dl = *(const GAS unsigned long long*)(F.DELTA + (size_t)t * D + col); T.sa = F.SA[t]; }
#pragma unroll
    for (int pl = 0; pl < 2; ++pl) T.a[pl] = *(const GAS v4u*)(F.ACT8 + (size_t)t * 128 + 64 * pl + 16 * kg);
}
DI void v_mfma_store(Frame& F, LAS unsigned char* wl, int s, int t, int lane, const v4u (&av)[2], f32x4 gv, unsigned long long dl, float sa) {
    const int n16 = lane & 15, kg = lane >> 4;
    const LAS unsigned char* rb = wl + (32 * kg + n16) * SLB;
    const int sw = (n16 >> 1) & 7;
    const i32x8v a0 = (i32x8v){(int)av[0].x, (int)av[0].y, (int)av[0].z, (int)av[0].w, 0, 0, 0, 0}, a1 = (i32x8v){(int)av[1].x, (int)av[1].y, (int)av[1].z, (int)av[1].w, 0, 0, 0, 0};
    float y[16];
#pragma unroll
    for (int cb = 0; cb < 16; ++cb) { const f32x4 z4 = {0.f, 0.f, 0.f, 0.f};
        const int off = (((cb >> 1) ^ sw) << 4) + 8 * (cb & 1);
        const i32x2 b0 = __builtin_amdgcn_ds_read_tr4_b64_v2i32((LAS i32x2*)(rb + off)), b1 = __builtin_amdgcn_ds_read_tr4_b64_v2i32((LAS i32x2*)(rb + 16 * SLB + off));
        const i32x8v bb = (i32x8v){b0[0], b0[1], b1[0], b1[1], 0, 0, 0, 0};
        const f32x4 acc0 = __builtin_amdgcn_mfma_scale_f32_16x16x128_f8f6f4(a0, bb, z4, 4, 4, 0, 0, 0, 0), acc1 = __builtin_amdgcn_mfma_scale_f32_16x16x128_f8f6f4(a1, bb, z4, 4, 4, 0, 0, 0, 0);
        y[cb] = acc0[0] + acc1[0] * (1.f / FP4_K2); }
    LAS float* tw = (LAS float*)wl;
#pragma unroll
    for (int q = 0; q < 4; ++q) { const float yq = kg == 0 ? y[q] : kg == 1 ? y[4 + q] : kg == 2 ? y[8 + q] : y[12 + q]; tw[(4 * kg + q) * 16 + n16] = yq; }
    const f32x4 yy = *(const LAS f32x4*)(tw + 4 * lane);
    const int col = 256 * s + 4 * lane;
    const unsigned dlo = (unsigned)dl, dhi = (unsigned)(dl >> 32);
    const float za = bflo(dlo) + gv.x * (sa * yy.x), zb = bfhi(dlo) + gv.y * (sa * yy.y), zc = bflo(dhi) + gv.z * (sa * yy.z), zd = bfhi(dhi) + gv.w * (sa * yy.w);
    *(GAS unsigned long long*)(F.Z + (size_t)t * D + col) = (unsigned long long)pkbf(za, zb) | ((unsigned long long)pkbf(zc, zd) << 32);
    const float ss = wave_sum(za * za + zb * zb + zc * zc + zd * zd);
    if (lane == 0) F.SSQ[(size_t)s * M + t] = ss;
}
DI void peer_v_phase(Frame& F) {
    int lane_o = F.lane; asm volatile("" : "+v"(lane_o));
    const int lane = lane_o, gq = lane >> 3, sub = lane & 7;
    LAS unsigned char* wl = F.lds + RING_OFF + F.wave * 16384;
    int x, sstep, t_lo, t_hi; slice_partition(F, x, sstep, t_lo, t_hi);
    for (int s = x; s < NSLU; s += sstep) {
        const __amdgpu_buffer_rsrc_t vbase = slice_rsrc(F.V8 + (size_t)s * NEXP * SLB); const unsigned suboff = 16u * (unsigned)sub;
        const int t0 = t_lo + F.wave;
        v4u en[2]; VTok T;
        { v4u e0[2]; u_idx(F, t0 < t_hi ? t0 : t_lo, gq, e0); v_load(F, vbase, suboff, s, lane, t0 < t_hi ? t0 : t_lo, e0, T); }
        u_idx(F, t0 + NWAVES < t_hi ? t0 + NWAVES : t_lo, gq, en);
        for (int t = t0; t < t_hi; t += NWAVES) {
            const int t1 = t + NWAVES < t_hi ? t + NWAVES : t_lo, t2 = t + 2 * NWAVES < t_hi ? t + 2 * NWAVES : t_lo;
            tile_stage(wl, lane, T.g);
            v4u ac[2];
#pragma unroll
            for (int pl = 0; pl < 2; ++pl) ac[pl] = T.a[pl];
            const f32x4 gc = T.gv; const unsigned long long dc = T.dl; const float sc = T.sa;
            v_load(F, vbase, suboff, s, lane, t1, en, T);
            u_idx(F, t2, gq, en);
            v_mfma_store(F, wl, s, t, lane, ac, gc, dc, sc);
        }
    }
}
DI void final_norm_phase(Frame& F) {
    LAS float* rs = (LAS float*)(F.lds + RING_OFF);
    const int lane = F.lane;
    for (int tb = F.vcu; tb < M / 64; tb += F.G) {
        __syncthreads();
        if (F.tid < 64) { const int t = tb * 64 + F.tid; float ss = 0.f;
#pragma unroll 8
            for (int s = 0; s < NSLU; ++s) ss += F.SSQ[(size_t)s * M + t];
            rs[F.tid] = 1.f / sqrtf(ss * (1.f / D) + EPS); }
        __syncthreads();
#pragma unroll 2
        for (int i = 0; i < 8; ++i) {
            const int t = tb * 64 + F.wave * 8 + i; const float rstd = rs[F.wave * 8 + i];
            const GAS unsigned long long* zp = (const GAS unsigned long long*)(F.Z + (size_t)t * D) + lane;
            GAS f32x4* op = (GAS f32x4*)(F.out + (size_t)t * D) + lane; const GAS f32x4* gp = (const GAS f32x4*)F.g_final + lane;
#pragma unroll
            for (int j = 0; j < 16; ++j) { const unsigned long long q = __builtin_nontemporal_load(zp + 64 * j); const unsigned lo = (unsigned)q, hi = (unsigned)(q >> 32); const f32x4 gf = gp[64 * j];
                f32x4 o; o.x = bflo(lo) * rstd * gf.x; o.y = bfhi(lo) * rstd * gf.y; o.z = bflo(hi) * rstd * gf.z; o.w = bfhi(hi) * rstd * gf.w; __builtin_nontemporal_store(o, op + 64 * j); }
        }
    }
}
struct Args { const float* in[17]; float* out; unsigned char* ws; int ph_lo, ph_hi, li, pad; };
__global__ void __launch_bounds__(NWAVES * 64, 2) peer_block_fwd(Args args) {
    extern __shared__ __attribute__((aligned(16))) unsigned char lds[];
    Frame F;
    F.lds = (LAS unsigned char*)lds;
    F.MISC = (volatile LAS unsigned*)(F.lds + MISC_OFF);
    F.tid = threadIdx.x; F.lane = F.tid & 63; F.wave = __builtin_amdgcn_readfirstlane(F.tid >> 6);
    F.G = gridDim.x; { const int bx = blockIdx.x; F.vcu = (F.G % 8 == 0) ? (bx % 8) * (F.G / 8) + bx / 8 : bx; }
    unsigned char* ws = args.ws;
    F.ctl = (gu32*)(ws + WS_CTL);
    F.x = args.in[0]; F.c = args.in[1]; F.w_ada = args.in[2]; F.b_ada = args.in[3]; F.g1 = args.in[4]; F.w_in = args.in[5]; F.g_ah = args.in[6]; F.w_pool = args.in[7]; F.s_pool = args.in[8];
    F.w_out = args.in[9]; F.g2 = args.in[10]; F.w_query = args.in[11]; F.sk1 = args.in[12]; F.sk2 = args.in[13]; F.u_exp = args.in[14]; F.v_exp = args.in[15]; F.g_final = args.in[16];
    F.out = args.out;
    F.MOD = (float*)(ws + WS_MOD); F.SK = (bf16*)(ws + WS_SK); F.WPS = (bf16*)(ws + WS_WPT); F.WQT = (bf16*)(ws + WS_WQT); F.WMIXT = (bf16*)(ws + WS_WOUTT); F.WINT = (bf16*)(ws + WS_WINT);
    F.H = (bf16*)(ws + WS_H); F.PROJ = (bf16*)(ws + WS_PROJ); F.CAT = (bf16*)(ws + WS_CAT); F.WOP = (bf16*)(ws + WS_DP); F.QP = (bf16*)(ws + WS_QP); F.DELTA = (bf16*)(ws + WS_X1);
    F.IDX = (unsigned short*)(ws + WS_IDX); F.GW = (float*)(ws + WS_GW);
    F.U8 = ws + WS_U8; F.V8 = ws + WS_V8; F.SU = (float*)(ws + WS_SU); F.SV = (float*)(ws + WS_SV);
    F.CAT8 = ws + WS_CAT8; F.WMIX8 = ws + WS_WMIX8; F.SCA = (float*)(ws + WS_SCA); F.SCB = (float*)(ws + WS_SCB);
    F.H8 = ws + WS_H8; F.SH = (float*)(ws + WS_SH); F.PD = (bf16*)(ws + WS_PD); F.ACT8 = ws + WS_ACT; F.SA = (float*)(ws + WS_ACT + 4 * MiB); F.SSQ = (float*)(ws + WS_SSQ); F.Z = (bf16*)(ws + WS_Z);
    for (int u = F.tid; u < (LDS_BYTES - LDSCTL_OFF) / 4; u += NWAVES * 64) ((LAS unsigned*)(F.lds + LDSCTL_OFF))[u] = 0u;
    __syncthreads();
    XcdBarrier bar; bar.bar = (unsigned*)(F.ctl + CW_BAR); bar.x = 0; bar.st = nullptr;
    if (N_LAUNCHES == 1) bar = xcd_barrier_post((unsigned*)(F.ctl + CW_BAR), F.MISC + 8);
    const int lo = args.ph_lo, hi = args.ph_hi;
#ifndef PHASE_MASK
#define PHASE_MASK 0x1fff
#endif
#define IN(k) (lo <= (k) && (k) < hi && ((PHASE_MASK >> (k)) & 1))
#define SEAM(k) do { if (IN(k) && IN((k) + 1)) xcd_barrier(bar); } while (0)
#ifndef PROBE_REP
#define PROBE_REP 0
#endif
#define REPS(k) (((PROBE_REP >> (k)) & 1) ? 2 : 1)
    const int NOGRP = 1 << 30;

    if (IN(0)) for (int rep_ = 0; rep_ < REPS(0); ++rep_) { if (rep_) xcd_barrier(bar); ph0_prologue(F); SEAM(0); }
    if (IN(1)) for (int rep_ = 0; rep_ < REPS(1); ++rep_) { if (rep_) xcd_barrier(bar);
        {
            pg8::Gemm g{F.WOP, F.WPS, D, DPOOL, PGRP, 2, (size_t)PGRP * 2, LDP, PGRP}; pg8::StaticOrder S; S.init(D, DPOOL, F.G, (int)blockIdx.x);
            pg8::EpiBf16<0> E{F.WMIXT + DATTN, LDK, nullptr, 0, 0, 1.f};
            pg8::gemm_phase<pg8::EpiBf16<0>, pg8::StaticOrder, true, true>(F.lds + RING_OFF, g, S, E);
        }
        norm_phase<false>(F, F.x, F.g1, 0, 1, F.H); SEAM(1); }
    if (IN(2)) for (int rep_ = 0; rep_ < REPS(2); ++rep_) { if (rep_) xcd_barrier(bar);
        pg8::Gemm g{F.H, F.WINT, M, NPROJ, D, NOGRP, 0, LDK, LDK}; pg8::StaticOrder S; S.init(M, NPROJ, F.G, (int)blockIdx.x);
        pg8::EpiProjHM E{F.PROJ, F.PROJ + (size_t)3 * M * DATTN, SEQ, NH, HD, DATTN, DPOOL};
        pg8::gemm_phase<pg8::EpiProjHM, pg8::StaticOrder, true, true>(F.lds + RING_OFF, g, S, E);
        SEAM(2);
    }
    if (IN(3)) for (int rep_ = 0; rep_ < REPS(3); ++rep_) { if (rep_) xcd_barrier(bar); mix_weight_fp8(F); pool_diff_phase(F); attn_phase(F);
#if defined(PROBE_POOL2)
        pool_diff_phase(F);
#endif
#if defined(PROBE_ATTN2)
        attn_phase(F);
#endif
        if (IN(3) && IN(5)) xcd_barrier(bar); }
    if (IN(5)) for (int rep_ = 0; rep_ < REPS(5); ++rep_) { if (rep_) xcd_barrier(bar);
        pg8::EpiG8WResid E{F.x, F.DELTA, D, F.MOD + 2 * D, MODW, SEQ, nullptr, 1.f / CAT_SCALE, F.SCB};
        pg8::gemm8w_phase<pg8::EpiG8WResid>(F.lds + RING_OFF, F.CAT8, F.WMIX8, M, D, D, D, D, F.G, (int)blockIdx.x, E);
        __syncthreads();
        SEAM(5);
    }
    if (IN(6)) for (int rep_ = 0; rep_ < REPS(6); ++rep_) { if (rep_) xcd_barrier(bar); norm_phase<true>(F, nullptr, F.g2, 3, 4, F.H); SEAM(6); }
    if (IN(7)) for (int rep_ = 0; rep_ < REPS(7); ++rep_) { if (rep_) xcd_barrier(bar);
        pg8::Gemm g{F.H, F.WQT, M, NQ, D, NOGRP, 0, LDK, LDK}; pg8::StaticOrder S; S.init(M, NQ, F.G, (int)blockIdx.x);
        pg8::EpiBf16<0> E{F.QP, PDQ, nullptr, PDQ, (size_t)M * PDQ, 1.f};
        pg8::gemm_phase<pg8::EpiBf16<0>, pg8::StaticOrder, true, true>(F.lds + RING_OFF, g, S, E);
        SEAM(7);
    }
    if (IN(8)) for (int rep_ = 0; rep_ < REPS(8); ++rep_) { if (rep_) xcd_barrier(bar); route_phase(F); SEAM(8); }
    if (IN(9)) for (int rep_ = 0; rep_ < REPS(9); ++rep_) { if (rep_) xcd_barrier(bar); peer_u_phase(F); SEAM(9); }
    if (IN(10)) for (int rep_ = 0; rep_ < REPS(10); ++rep_) { if (rep_) xcd_barrier(bar); peer_act_phase(F); SEAM(10); }
    if (IN(11)) for (int rep_ = 0; rep_ < REPS(11); ++rep_) { if (rep_) xcd_barrier(bar); peer_v_phase(F); SEAM(11); }
    if (IN(12)) for (int rep_ = 0; rep_ < REPS(12); ++rep_) { if (rep_) xcd_barrier(bar); final_norm_phase(F); }
#undef IN
#undef SEAM
}

extern "C" void kernel_launch(void* const* d_in, const int* in_sizes, int n_in, void* d_out, int out_size, void* d_ws, size_t ws_size, hipStream_t stream) {
    static int grid = 0;
    if (grid == 0) {
        if (n_in != 17 || in_sizes[0] != M * D || out_size != M * D || ws_size < WS_END) { fprintf(stderr, "kernel_launch: built for 17 inputs, x/out of %d floats, >= %zu bytes of workspace; got n_in %d, in0 %d, out %d, ws %zu; nothing launched\n", M * D, (size_t)WS_END, n_in, n_in > 0 ? in_sizes[0] : -1, out_size, ws_size); grid = -1; return; }
        int dev = 0, cus = 0, per_cu = 0;
        if (hipGetDevice(&dev) != hipSuccess || hipDeviceGetAttribute(&cus, hipDeviceAttributeMultiprocessorCount, dev) != hipSuccess) { fprintf(stderr, "kernel_launch: hipGetDevice / hipDeviceGetAttribute failed\n"); grid = -1; return; }
        if (hipFuncSetAttribute((const void*)peer_block_fwd, hipFuncAttributeMaxDynamicSharedMemorySize, LDS_BYTES) != hipSuccess) { fprintf(stderr, "kernel_launch: hipFuncSetAttribute failed\n"); grid = -1; return; }
        if (hipOccupancyMaxActiveBlocksPerMultiprocessor(&per_cu, (const void*)peer_block_fwd, NWAVES * 64, LDS_BYTES) != hipSuccess || per_cu < 1)
            fprintf(stderr, "kernel_launch: note: occupancy query reports %d workgroups per CU\n", per_cu);
        (void)hipGetLastError();
        grid = cus;
    }
    if (grid < 0) return;
    if (hipMemsetAsync((char*)d_ws + WS_CTL, 0, CTL_ZERO_BYTES, stream) != hipSuccess) { fprintf(stderr, "kernel_launch: hipMemsetAsync failed\n"); return; }
    Args a{};
    for (int i = 0; i < 17; ++i) a.in[i] = (const float*)d_in[i];
    a.out = (float*)d_out; a.ws = (unsigned char*)d_ws;
    for (int li = 0; li < N_LAUNCHES; ++li) {
        a.ph_lo = (N_LAUNCHES == 1) ? 0 : li; a.ph_hi = (N_LAUNCHES == 1) ? NPHASE : li + 1; a.li = li;
        hipLaunchKernelGGL(peer_block_fwd, dim3(grid), dim3(NWAVES * 64), LDS_BYTES, stream, a);
        const hipError_t le = hipPeekAtLastError();
        if (le != hipSuccess) { fprintf(stderr, "kernel_launch: launch %d failed: %s\n", li, hipGetErrorName(le)); break; }
    }
}
```

```cpp
#include <hip/hip_runtime.h>
#include <cstdio>
#include <cstdint>
namespace pg8 {
#define PG8_LAS __attribute__((address_space(3)))
typedef unsigned short bf16_t;
typedef short bf16x8 __attribute__((ext_vector_type(8)));
typedef float f32x4 __attribute__((ext_vector_type(4)));
typedef unsigned u32x4 __attribute__((ext_vector_type(4)));
constexpr int BM = 256, BK = 64, HALF = 128, HTB = HALF * BK * 2  , STAGE_BYTES = 8 * HTB, NXCD = 8, WGM = 8;

__host__ __device__ __forceinline__ int lds_byte(int r, int c) { const int st = (r >> 4) * 2 + (c >> 5), rr = r & 15, cc = c & 31, ob = rr * 64 + cc * 2; return st * 1024 + (ob ^ (((ob >> 9) & 1) << 5)); }
__host__ __device__ __forceinline__ void stage_rc(int b, int& R, int& C) { const int st = b / 1024, sb = b % 1024, swz = sb ^ (((sb >> 9) & 1) << 5); R = (st >> 1) * 16 + swz / 64; C = (st & 1) * 32 + (swz % 64) / 2; }
__host__ __device__ __forceinline__ int perm32(int rho) { const int n = rho >> 4, i = rho & 15; return 8 * (i >> 2) + 4 * n + (i & 3); }

struct Unit { int pm, pn; };
struct Gemm { const bf16_t* A; const bf16_t* Bt; int M, N, K; int png; size_t agb; int lda, ldb; };

struct StaticOrder {
    int nM, nN, nwg, G, c;
    __host__ __device__ void init(int M, int N, int G_, int c_) { nM = M / BM; nN = N / BM; nwg = nM * nN; G = G_; c = c_; }
    __host__ __device__ bool next(int i, Unit& u) const {
        const long L = (long)i * G + c; if (L >= nwg) return false;
        int wgid = (int)L; { const int q = nwg / NXCD, r = nwg % NXCD, xcd = wgid % NXCD, off = wgid / NXCD; wgid = (xcd < r ? xcd * (q + 1) : r * (q + 1) + (xcd - r) * q) + off; }
        const int nig = WGM * nN, gid = wgid / nig, fm = gid * WGM, gsz = (nM - fm) < WGM ? (nM - fm) : WGM;
        u.pm = fm + ((wgid % nig) % gsz); u.pn = (wgid % nig) / gsz; return true;
    }
    __device__ __forceinline__ void a_ready(const Unit&) const {}
    __device__ __forceinline__ void done(const Unit&) const {}
};

__device__ __forceinline__ unsigned cvt_pk_bf16(float lo, float hi) { unsigned r; asm volatile("v_cvt_pk_bf16_f32 %0, %1, %2" : "=v"(r) : "v"(lo), "v"(hi)); return r; }
typedef float f32x2 __attribute__((ext_vector_type(2)));
__device__ __forceinline__ f32x2 gelu_pk(f32x2 v) {
    const f32x2 av = __builtin_elementwise_abs(v), d = av * 0.2316418882f + 1.0f;
    f32x2 t; t.x = __builtin_amdgcn_rcpf(d.x); t.y = __builtin_amdgcn_rcpf(d.y);
    f32x2 q = t * 0.5307027145f + (-0.7265760135f); q = q * t + 0.7107068705f; q = q * t + (-0.142248368f); q = q * t + 0.127414796f; q = q * t;
    const f32x2 s = (v * v) * (-0.72134752044f);
    f32x2 e; e.x = __builtin_amdgcn_exp2f(s.x); e.y = __builtin_amdgcn_exp2f(s.y);
    const f32x2 m = v * (q * e), r = v - m;
    f32x2 o; o.x = v.x < 0.f ? m.x : r.x; o.y = v.y < 0.f ? m.y : r.y; return o;
}

template <int ACT  > struct EpiBf16 {
    static constexpr bool PERM = true, AFTER_DRAIN = false; static_assert(ACT == 0 || ACT == 1, "EpiBf16: ACT is 0 (none) or 1 (gelu_pk)");
    bf16_t* O; int ldc; const float* bias; int split_cols; size_t split_stride; float scale0;
    __device__ __forceinline__ void operator()(const f32x4 (&acc)[2][2][4][2], const Unit& u, int wr, int wc, int fr, int fq) const {
        const int row0 = u.pm * BM + wr * 64 + fr; int colt = u.pn * BM; bf16_t* base = O;
        float sc = 1.f; if (split_cols) { const int t = colt / split_cols; base += (size_t)t * split_stride; colt -= t * split_cols; if (t == 0) sc = scale0; }
        const int col0 = colt + wc * 32 + 8 * fq, bcol0 = u.pn * BM + wc * 32 + 8 * fq;
        f32x4 bv[2][2];
#pragma unroll
        for (int bj = 0; bj < 2; ++bj)
#pragma unroll
            for (int n = 0; n < 2; ++n) bv[bj][n] = bias ? *(const f32x4*)(bias + bcol0 + bj * HALF + 4 * n) : (f32x4){0.f, 0.f, 0.f, 0.f};
#pragma unroll
        for (int ai = 0; ai < 2; ++ai)
#pragma unroll
            for (int m = 0; m < 4; ++m) { bf16_t* rowp = base + (size_t)(row0 + ai * HALF + m * 16) * ldc + col0;
#pragma unroll
                for (int bj = 0; bj < 2; ++bj) { f32x4 v0 = acc[ai][bj][m][0] + bv[bj][0], v1 = acc[ai][bj][m][1] + bv[bj][1];
                    if (ACT == 1) { f32x2 a = gelu_pk((f32x2){v0[0], v0[1]}), b = gelu_pk((f32x2){v0[2], v0[3]}), c = gelu_pk((f32x2){v1[0], v1[1]}), d = gelu_pk((f32x2){v1[2], v1[3]});
                        v0 = (f32x4){a.x, a.y, b.x, b.y}; v1 = (f32x4){c.x, c.y, d.x, d.y}; }
                    v0 = v0 * sc; v1 = v1 * sc; u32x4 w; w.x = cvt_pk_bf16(v0[0], v0[1]); w.y = cvt_pk_bf16(v0[2], v0[3]); w.z = cvt_pk_bf16(v1[0], v1[1]); w.w = cvt_pk_bf16(v1[2], v1[3]);
                    *(u32x4*)(rowp + bj * HALF) = w; } }
    }
};
constexpr int M_ROWS = 16384;
struct EpiScaleBf16 {
    static constexpr bool PERM = true, AFTER_DRAIN = false;
    bf16_t* O; int ldc; const float* cs; int cs_bstride; int rows_per_batch;
    __device__ __forceinline__ void operator()(const f32x4 (&acc)[2][2][4][2], const Unit& u, int wr, int wc, int fr, int fq) const {
        const int row0 = u.pm * BM + wr * 64 + fr, col0 = u.pn * BM + wc * 32 + 8 * fq;
        const float* cs = this->cs + (size_t)((u.pm * BM) / rows_per_batch) * cs_bstride;
        f32x4 sv[2][2];
#pragma unroll
        for (int bj = 0; bj < 2; ++bj)
#pragma unroll
            for (int n = 0; n < 2; ++n) sv[bj][n] = *(const f32x4*)(cs + col0 + bj * HALF + 4 * n);
#pragma unroll
        for (int ai = 0; ai < 2; ++ai)
#pragma unroll
            for (int m = 0; m < 4; ++m) { bf16_t* rowp = O + (size_t)(row0 + ai * HALF + m * 16) * ldc + col0;
#pragma unroll
                for (int bj = 0; bj < 2; ++bj) { const f32x4 v0 = acc[ai][bj][m][0] * sv[bj][0], v1 = acc[ai][bj][m][1] * sv[bj][1];
                    u32x4 w; w.x = cvt_pk_bf16(v0[0], v0[1]); w.y = cvt_pk_bf16(v0[2], v0[3]); w.z = cvt_pk_bf16(v1[0], v1[1]); w.w = cvt_pk_bf16(v1[2], v1[3]);
                    *(u32x4*)(rowp + bj * HALF) = w; } }
    }
};
struct EpiResid {
    static constexpr bool PERM = false, AFTER_DRAIN = false;
    const float* X; float* O; int ldc; const float* gate; int gate_bstride; int rows_per_batch;
    __device__ __forceinline__ void operator()(const f32x4 (&acc)[2][2][4][2], const Unit& u, int wr, int wc, int fr, int fq) const {
        const int row0 = u.pm * BM + wr * 64 + fr, col0 = u.pn * BM + wc * 32 + 4 * fq;
        const float* gp = gate + (size_t)((u.pm * BM) / rows_per_batch) * gate_bstride + col0;
        f32x4 gv[2][2];
#pragma unroll
        for (int bj = 0; bj < 2; ++bj)
#pragma unroll
            for (int n = 0; n < 2; ++n) gv[bj][n] = *(const f32x4*)(gp + bj * HALF + 16 * n);
#pragma unroll
        for (int ai = 0; ai < 2; ++ai)
#pragma unroll
            for (int m = 0; m < 4; ++m) { const size_t ro = (size_t)(row0 + ai * HALF + m * 16) * ldc + col0;
#pragma unroll
                for (int bj = 0; bj < 2; ++bj)
#pragma unroll
                    for (int n = 0; n < 2; ++n) { const f32x4 xv = *(const f32x4*)(X + ro + bj * HALF + 16 * n);
                        *(f32x4*)(O + ro + bj * HALF + 16 * n) = xv + gv[bj][n] * acc[ai][bj][m][n]; } }
    }
};
struct EpiProjHM {
    static constexpr bool PERM = true, AFTER_DRAIN = false;
    bf16_t* QKV; bf16_t* P; int seq, nheads, hd, dattn, dpool;
    __device__ __forceinline__ void operator()(const f32x4 (&acc)[2][2][4][2], const Unit& u, int wr, int wc, int fr, int fq) const {
        const int row0 = u.pm * BM + wr * 64 + fr, colt = u.pn * BM, cin = wc * 32 + 8 * fq;
        const int sec = colt / dattn;
#pragma unroll
        for (int ai = 0; ai < 2; ++ai)
#pragma unroll
            for (int m = 0; m < 4; ++m) { const int row = row0 + ai * HALF + m * 16, b = row / seq, t = row - b * seq;
#pragma unroll
                for (int bj = 0; bj < 2; ++bj) { const f32x4 v0 = acc[ai][bj][m][0], v1 = acc[ai][bj][m][1];
                    u32x4 w; w.x = cvt_pk_bf16(v0[0], v0[1]); w.y = cvt_pk_bf16(v0[2], v0[3]); w.z = cvt_pk_bf16(v1[0], v1[1]); w.w = cvt_pk_bf16(v1[2], v1[3]);
                    bf16_t* dst;
                    if (sec < 3) { const int head = (colt - sec * dattn) / hd + bj; dst = QKV + (size_t)sec * seq * (size_t)(dattn * (M_ROWS / seq)) + ((size_t)(b * nheads + head) * seq + t) * hd + cin; }
                    else dst = P + (size_t)row * dpool + (colt - 3 * dattn) + bj * HALF + cin;
                    *(u32x4*)dst = w; } }
    }
};
struct EpiResidBf16 {
    static constexpr bool PERM = true, AFTER_DRAIN = false;
    const float* X; bf16_t* O; int ldc; const float* gate; int gate_bstride; int rows_per_batch;
    __device__ __forceinline__ void operator()(const f32x4 (&acc)[2][2][4][2], const Unit& u, int wr, int wc, int fr, int fq) const {
        const int row0 = u.pm * BM + wr * 64 + fr, col0 = u.pn * BM + wc * 32 + 8 * fq;
        const float* gp = gate + (size_t)((u.pm * BM) / rows_per_batch) * gate_bstride + col0;
        f32x4 gv[2][2];
#pragma unroll
        for (int bj = 0; bj < 2; ++bj)
#pragma unroll
            for (int n = 0; n < 2; ++n) gv[bj][n] = *(const f32x4*)(gp + bj * HALF + 4 * n);
#pragma unroll
        for (int ai = 0; ai < 2; ++ai)
#pragma unroll
            for (int m = 0; m < 4; ++m) { const size_t ro = (size_t)(row0 + ai * HALF + m * 16) * ldc + col0;
#pragma unroll
                for (int bj = 0; bj < 2; ++bj) { const f32x4 x0 = *(const f32x4*)(X + ro + bj * HALF), x1 = *(const f32x4*)(X + ro + bj * HALF + 4);
                    const f32x4 v0 = x0 + gv[bj][0] * acc[ai][bj][m][0], v1 = x1 + gv[bj][1] * acc[ai][bj][m][1];
                    u32x4 w; w.x = cvt_pk_bf16(v0[0], v0[1]); w.y = cvt_pk_bf16(v0[2], v0[3]); w.z = cvt_pk_bf16(v1[0], v1[1]); w.w = cvt_pk_bf16(v1[2], v1[3]);
                    *(u32x4*)(O + ro + bj * HALF) = w; } }
    }
};

template <class Epi, class Sched, bool ALIGN_EPI = false, bool SP2 = false>
__device__ __forceinline__ void gemm_phase(PG8_LAS unsigned char* lds, const Gemm g, const Sched& S, const Epi& E) {
    const int tid = threadIdx.x, wid = __builtin_amdgcn_readfirstlane(tid >> 6), lane = tid & 63, wr = wid >> 2, wc = wid & 3, fr = lane & 15, fq = lane >> 4;
    const int K = g.K, nt = K / BK;
    unsigned voffA[2], voffB[2];
#pragma unroll
    for (int i = 0; i < 2; ++i) { int R, C; stage_rc(tid * 16 + i * 8192, R, C); const int Rb = Epi::PERM ? ((R & ~31) + perm32(R & 31)) : R;
        voffA[i] = (unsigned)(R * g.lda + C) * 2u; voffB[i] = (unsigned)(Rb * g.ldb + C) * 2u; }
    const size_t kstep = (size_t)(BK * 2);
    const size_t hstepA = (size_t)HALF * g.lda * 2, hstepB = (size_t)HALF * g.ldb * 2;
    const size_t tstepA = 2 * hstepA, tstepB = 2 * hstepB;
    const unsigned ldsw = (unsigned)wid * 1024u;
    const int aoff = lds_byte(wr * 64 + fr, fq * 8), boff = lds_byte(wc * 32 + fr, fq * 8);
#define PG8_SA(b, h) (((b) * 2 + (h)) * HTB)
#define PG8_SB(b, h) ((4 + (b) * 2 + (h)) * HTB)
#define PG8_STAGE(bufoff, gbase, voff) do { _Pragma("unroll") for (int _i = 0; _i < 2; ++_i) \
        __builtin_amdgcn_global_load_lds((const unsigned*)((const char*)(gbase) + (voff)[_i]), (PG8_LAS unsigned*)(lds + (bufoff) + ldsw + _i * 8192), 16, 0, 0); } while (0)
#define PG8_LDA(dst, b, h) do { _Pragma("unroll") for (int m = 0; m < 4; ++m) _Pragma("unroll") for (int k = 0; k < 2; ++k) dst[m][k] = *(const PG8_LAS bf16x8*)(lds + PG8_SA(b, h) + aoff + m * 2048 + k * 1024); } while (0)
#define PG8_LDB(dst, b, h) do { _Pragma("unroll") for (int n = 0; n < 2; ++n) _Pragma("unroll") for (int k = 0; k < 2; ++k) dst[n][k] = *(const PG8_LAS bf16x8*)(lds + PG8_SB(b, h) + boff + n * 2048 + k * 1024); } while (0)
#define PG8_MMA(ai, bj, At, Bt) do { __builtin_amdgcn_s_setprio(1); _Pragma("unroll") for (int m = 0; m < 4; ++m) _Pragma("unroll") for (int n = 0; n < 2; ++n) _Pragma("unroll") for (int k = 0; k < 2; ++k) \
        acc[ai][bj][m][n] = __builtin_amdgcn_mfma_f32_16x16x32_bf16(Bt[n][k], At[m][k], acc[ai][bj][m][n], 0, 0, 0); __builtin_amdgcn_s_setprio(0); } while (0)
#define PG8_WAIT_V(n) asm volatile("s_waitcnt vmcnt(" #n ")" ::: "memory")
#define PG8_WAIT_L(n) asm volatile("s_waitcnt lgkmcnt(" #n ")" ::: "memory")
#define PG8_BAR __builtin_amdgcn_s_barrier()
#define PG8_SCHED __builtin_amdgcn_sched_barrier(0)
    Unit cur, nxt; int ui = 0;
    if (!S.next(0, cur)) return;
    f32x4 acc[2][2][4][2];
#pragma unroll
    for (int a = 0; a < 2; ++a)
#pragma unroll
        for (int b = 0; b < 2; ++b)
#pragma unroll
            for (int m = 0; m < 4; ++m)
#pragma unroll
                for (int n = 0; n < 2; ++n) acc[a][b][m][n] = (f32x4){0.f, 0.f, 0.f, 0.f};
    bf16x8 At[4][2], B0[2][2], B1[2][2];
    const char* cA = (const char*)g.A + (size_t)cur.pm * tstepA + (size_t)(cur.pn / g.png) * g.agb; const char* cB = (const char*)g.Bt + (size_t)cur.pn * tstepB;
    S.a_ready(cur);
    if constexpr (SP2) {
        PG8_STAGE(PG8_SB(0, 0), cB, voffB); PG8_STAGE(PG8_SB(0, 1), cB + hstepB, voffB); PG8_STAGE(PG8_SA(0, 0), cA, voffA); PG8_STAGE(PG8_SA(0, 1), cA + hstepA, voffA);
        if (wr == 1) PG8_BAR;
        PG8_WAIT_V(2); PG8_BAR;
        PG8_STAGE(PG8_SB(1, 0), cB + kstep, voffB); PG8_STAGE(PG8_SA(1, 0), cA + kstep, voffA); PG8_STAGE(PG8_SB(1, 1), cB + hstepB + kstep, voffB);
        PG8_WAIT_V(6); PG8_BAR;
    } else {
        PG8_STAGE(PG8_SB(0, 0), cB, voffB); PG8_STAGE(PG8_SA(0, 0), cA, voffA); PG8_STAGE(PG8_SB(0, 1), cB + hstepB, voffB); PG8_STAGE(PG8_SA(0, 1), cA + hstepA, voffA);
        if (wr == 1) PG8_BAR;
        PG8_WAIT_V(4); PG8_BAR;
        PG8_STAGE(PG8_SB(1, 0), cB + kstep, voffB); PG8_STAGE(PG8_SA(1, 0), cA + kstep, voffA); PG8_STAGE(PG8_SB(1, 1), cB + hstepB + kstep, voffB);
        PG8_WAIT_V(6); PG8_BAR;
    }
    for (;;) {
        const bool has_next = S.next(ui + 1, nxt);
        const char* nA = has_next ? (const char*)g.A + (size_t)nxt.pm * tstepA + (size_t)(nxt.pn / g.png) * g.agb : cA; const char* nB = has_next ? (const char*)g.Bt + (size_t)nxt.pn * tstepB : cB;
        for (int t = 0; t < nt; t += 2) {
            const bool last = (t == nt - 2);
            const char* a1 = cA + (size_t)(t + 1) * kstep;
            const char* a2 = last ? nA : cA + (size_t)(t + 2) * kstep; const char* b2 = last ? nB : cB + (size_t)(t + 2) * kstep;
            const char* a3 = a2 + kstep; const char* b3 = b2 + kstep;
            if (last && has_next) S.a_ready(nxt);
            if constexpr (SP2) {
            PG8_LDB(B0, 0, 0); PG8_LDB(B1, 0, 1); PG8_SCHED; PG8_LDA(At, 0, 0); PG8_STAGE(PG8_SA(1, 1), a1 + hstepA, voffA);
            PG8_WAIT_V(8); PG8_WAIT_L(0); PG8_BAR; PG8_MMA(0, 0, At, B0); PG8_MMA(0, 1, At, B1); PG8_BAR; PG8_SCHED;
            PG8_LDA(At, 0, 1); PG8_STAGE(PG8_SB(0, 0), b2, voffB); PG8_STAGE(PG8_SB(0, 1), b2 + hstepB, voffB); PG8_STAGE(PG8_SA(0, 0), a2, voffA);
            PG8_WAIT_V(8); PG8_WAIT_L(0); PG8_BAR; PG8_MMA(1, 0, At, B0); PG8_MMA(1, 1, At, B1); PG8_BAR; PG8_SCHED;
            PG8_LDB(B0, 1, 0); PG8_LDB(B1, 1, 1); PG8_SCHED; PG8_LDA(At, 1, 0); PG8_STAGE(PG8_SA(0, 1), a2 + hstepA, voffA);
            PG8_WAIT_V(8); PG8_WAIT_L(0); PG8_BAR; PG8_MMA(0, 0, At, B0); PG8_MMA(0, 1, At, B1); PG8_BAR; PG8_SCHED;
            PG8_LDA(At, 1, 1); PG8_STAGE(PG8_SB(1, 0), b3, voffB); PG8_STAGE(PG8_SB(1, 1), b3 + hstepB, voffB); PG8_STAGE(PG8_SA(1, 0), a3, voffA);
            PG8_WAIT_V(8); PG8_WAIT_L(0); PG8_BAR; PG8_MMA(1, 0, At, B0); PG8_MMA(1, 1, At, B1); PG8_BAR; PG8_SCHED;
            } else {
            PG8_LDB(B0, 0, 0); PG8_SCHED; PG8_LDA(At, 0, 0); PG8_STAGE(PG8_SA(1, 1), a1 + hstepA, voffA);
            PG8_WAIT_L(8); PG8_BAR; PG8_WAIT_L(0); PG8_MMA(0, 0, At, B0); PG8_BAR; PG8_SCHED;
            PG8_LDB(B1, 0, 1); PG8_STAGE(PG8_SB(0, 0), b2, voffB);
            PG8_BAR; PG8_WAIT_L(0); PG8_MMA(0, 1, At, B1); PG8_BAR;
            PG8_LDA(At, 0, 1); PG8_STAGE(PG8_SA(0, 0), a2, voffA);
            PG8_BAR; PG8_WAIT_L(0); PG8_MMA(1, 0, At, B0); PG8_BAR; PG8_SCHED;
            PG8_STAGE(PG8_SB(0, 1), b2 + hstepB, voffB);
            PG8_WAIT_V(6); PG8_BAR; PG8_MMA(1, 1, At, B1); PG8_BAR;
            PG8_LDB(B0, 1, 0); PG8_SCHED; PG8_LDA(At, 1, 0); PG8_STAGE(PG8_SA(0, 1), a2 + hstepA, voffA);
            PG8_WAIT_L(8); PG8_BAR; PG8_WAIT_L(0); PG8_MMA(0, 0, At, B0); PG8_BAR; PG8_SCHED;
            PG8_LDB(B1, 1, 1); PG8_STAGE(PG8_SB(1, 0), b3, voffB);
            PG8_BAR; PG8_WAIT_L(0); PG8_MMA(0, 1, At, B1); PG8_BAR;
            PG8_LDA(At, 1, 1); PG8_STAGE(PG8_SA(1, 0), a3, voffA);
            PG8_BAR; PG8_WAIT_L(0); PG8_MMA(1, 0, At, B0); PG8_BAR; PG8_SCHED;
            PG8_STAGE(PG8_SB(1, 1), b3 + hstepB, voffB);
            PG8_WAIT_V(6); PG8_BAR; PG8_MMA(1, 1, At, B1); PG8_BAR;
            }
        }
        if constexpr (ALIGN_EPI) { if (wr == 0) PG8_BAR; }
        if constexpr (!Epi::AFTER_DRAIN) { E(acc, cur, wr, wc, fr, fq); S.done(cur); }
        if (!has_next) break;
#pragma unroll
        for (int a = 0; a < 2; ++a)
#pragma unroll
            for (int b = 0; b < 2; ++b)
#pragma unroll
                for (int m = 0; m < 4; ++m)
#pragma unroll
                    for (int n = 0; n < 2; ++n) acc[a][b][m][n] = (f32x4){0.f, 0.f, 0.f, 0.f};
        cur = nxt; cA = nA; cB = nB; ++ui;
        if constexpr (ALIGN_EPI) { if (wr == 1) PG8_BAR; }
    }
    PG8_WAIT_V(0);
    if constexpr (!ALIGN_EPI) { if (wr == 0) PG8_BAR; }
    PG8_BAR;
    if constexpr (Epi::AFTER_DRAIN) { E.fused(acc, cur, wr, wc, fr, fq, lds, wid, lane); S.done(cur); }
#undef PG8_SA
#undef PG8_SB
#undef PG8_STAGE
#undef PG8_LDA
#undef PG8_LDB
#undef PG8_MMA
#undef PG8_WAIT_V
#undef PG8_WAIT_L
#undef PG8_BAR
#undef PG8_SCHED
}
}
namespace pg8 {
typedef int i32x4_t __attribute__((ext_vector_type(4)));
typedef int i32x8_t __attribute__((ext_vector_type(8)));
__device__ __forceinline__ i32x8_t cat8(bf16x8 lo, bf16x8 hi) { return __builtin_shufflevector(__builtin_bit_cast(i32x4_t, lo), __builtin_bit_cast(i32x4_t, hi), 0, 1, 2, 3, 4, 5, 6, 7); }
__device__ __forceinline__ f32x4 mma_f8(i32x8_t B, i32x8_t A, f32x4 c) { return __builtin_amdgcn_mfma_scale_f32_16x16x128_f8f6f4(B, A, c, 0, 0, 0, 0, 0, 0); }
struct Order8 {
    int nM, nN, nwg, G, c;
    __device__ void init(int M, int N, int G_, int c_) { nM = M / 256; nN = N / 128; nwg = nM * nN; G = G_; c = c_; }
    __device__ bool next(int i, int& pm, int& pn) const {
        const long L = (long)i * G + c; if (L >= nwg) return false;
        int wgid = (int)L; { const int q = nwg / NXCD, r = nwg % NXCD, xcd = wgid % NXCD, off = wgid / NXCD; wgid = (xcd < r ? xcd * (q + 1) : r * (q + 1) + (xcd - r) * q) + off; }
        const int nig = WGM * nN, gid = wgid / nig, fm = gid * WGM, gsz = (nM - fm) < WGM ? (nM - fm) : WGM;
        pm = fm + ((wgid % nig) % gsz); pn = (wgid % nig) / gsz; return true;
    }
};
struct EpiG8Resid {
    const float* X; bf16_t* O; int ldc; const float* gate; int gate_bstride; int rows_per_batch; const float* sa; float sa_const; const float* sb;
    __device__ __forceinline__ void operator()(const f32x4 (&acc)[4][4], int pm, int pn, int wr, int wc, int fr_, int fq_) const {
        int fr = fr_, fq = fq_; asm volatile("" : "+v"(fr), "+v"(fq));
        const int row0 = pm * 256 + wr * 64 + fr, colb = pn * 128 + wc * 64 + 8 * fq;
        const float* gp = gate + (size_t)((pm * 256) / rows_per_batch) * gate_bstride + colb;
        f32x4 gv[2][2];
#pragma unroll
        for (int g2 = 0; g2 < 2; ++g2)
#pragma unroll
            for (int q = 0; q < 2; ++q) gv[g2][q] = *(const f32x4*)(gp + 32 * g2 + 4 * q) * *(const f32x4*)(sb + colb + 32 * g2 + 4 * q);
#pragma unroll
        for (int m = 0; m < 4; ++m) { const int row = row0 + 16 * m; const size_t ro = (size_t)row * ldc + colb; const float rs = sa ? sa[row] : sa_const;
#pragma unroll
            for (int g2 = 0; g2 < 2; ++g2) { const f32x4 x0 = *(const f32x4*)(X + ro + 32 * g2), x1 = *(const f32x4*)(X + ro + 32 * g2 + 4);
                const f32x4 v0 = x0 + gv[g2][0] * (acc[m][2 * g2] * rs), v1 = x1 + gv[g2][1] * (acc[m][2 * g2 + 1] * rs);
                u32x4 w; w.x = cvt_pk_bf16(v0[0], v0[1]); w.y = cvt_pk_bf16(v0[2], v0[3]); w.z = cvt_pk_bf16(v1[0], v1[1]); w.w = cvt_pk_bf16(v1[2], v1[3]);
                *(u32x4*)(O + ro + 32 * g2) = w; } }
    }
};
template <class Epi>
__device__ __forceinline__ void gemm8_phase(PG8_LAS unsigned char* lds, const unsigned char* A, const unsigned char* B, int M, int N, int K, int lda, int ldb, int G, int cidx, const Epi& E) {
    const int tid = threadIdx.x, wid = __builtin_amdgcn_readfirstlane(tid >> 6), lane = tid & 63, wr = wid >> 1, wc = wid & 1, fr = lane & 15, fq = lane >> 4;
    unsigned voffA[2], voffB[2];
#pragma unroll
    for (int i = 0; i < 2; ++i) { int R, C; stage_rc(tid * 16 + i * 8192, R, C); const int Rb = (R & ~31) + perm32(R & 31);
        voffA[i] = (unsigned)(R * lda + 2 * C); voffB[i] = (unsigned)(Rb * ldb + 2 * C); }
    const unsigned ldsw = (unsigned)wid * 1024u;
    const int aoff = (wr >> 1) * HTB + lds_byte(64 * (wr & 1) + fr, fq * 8), boff = 2 * HTB + lds_byte(64 * wc + fr, fq * 8);
    constexpr int SS = 3 * HTB;
    const int nt = K / 128;
    Order8 S; S.init(M, N, G, cidx);
#define G8_STAGE1(bufoff, gptr, voff) do { _Pragma("unroll") for (int _i = 0; _i < 2; ++_i) \
        __builtin_amdgcn_global_load_lds((const unsigned*)((const char*)(gptr) + (voff)[_i]), (PG8_LAS unsigned*)(lds + (bufoff) + ldsw + _i * 8192), 16, 0, 0); } while (0)
#define G8_STAGE3(s, kt) do { const size_t ko_ = (size_t)(kt) * 128; G8_STAGE1((s) * SS, gA + ko_, voffA); G8_STAGE1((s) * SS + HTB, gA + (size_t)128 * lda + ko_, voffA); G8_STAGE1((s) * SS + 2 * HTB, gB + ko_, voffB); } while (0)
#define G8_LDF(FA, FB, s) do { _Pragma("unroll") for (int m = 0; m < 4; ++m) { const bf16x8 l0_ = *(const PG8_LAS bf16x8*)(lds + (s) * SS + aoff + m * 2048), l1_ = *(const PG8_LAS bf16x8*)(lds + (s) * SS + aoff + m * 2048 + 1024); FA[m] = cat8(l0_, l1_); } \
        _Pragma("unroll") for (int n = 0; n < 4; ++n) { const bf16x8 l0_ = *(const PG8_LAS bf16x8*)(lds + (s) * SS + boff + n * 2048), l1_ = *(const PG8_LAS bf16x8*)(lds + (s) * SS + boff + n * 2048 + 1024); FB[n] = cat8(l0_, l1_); } } while (0)
#define G8_MMA(FA, FB) do { __builtin_amdgcn_s_setprio(1); _Pragma("unroll") for (int m = 0; m < 4; ++m) _Pragma("unroll") for (int n = 0; n < 4; ++n) acc[m][n] = mma_f8(FB[n], FA[m], acc[m][n]); __builtin_amdgcn_s_setprio(0); } while (0)
#define G8_WAIT_V0 asm volatile("s_waitcnt vmcnt(0)" ::: "memory")
#define G8_WAIT_L0 asm volatile("s_waitcnt lgkmcnt(0)" ::: "memory")
#define G8_BAR __builtin_amdgcn_s_barrier()
#define G8_SCHED __builtin_amdgcn_sched_barrier(0)
    for (int ui = 0;; ++ui) {
        int pm, pn; if (!S.next(ui, pm, pn)) break;
        const char* gA = (const char*)A + (size_t)pm * 256 * lda; const char* gB = (const char*)B + (size_t)pn * 128 * ldb;
        f32x4 acc[4][4];
#pragma unroll
        for (int m = 0; m < 4; ++m)
#pragma unroll
            for (int n = 0; n < 4; ++n) acc[m][n] = (f32x4){0.f, 0.f, 0.f, 0.f};
        i32x8_t A0[4], B0[4], A1[4], B1[4];
        G8_BAR;
        G8_STAGE3(0, 0); G8_WAIT_V0; G8_BAR;
        G8_STAGE3(1, 1);
        G8_LDF(A0, B0, 0); G8_WAIT_L0; G8_SCHED;
        for (int kt = 0; kt < nt; kt += 2) {
            G8_WAIT_V0; G8_BAR; G8_SCHED;
            if (kt + 2 < nt) G8_STAGE3(0, kt + 2);
            G8_LDF(A1, B1, 1); G8_SCHED;
            G8_MMA(A0, B0);
            G8_WAIT_L0; G8_SCHED;
            G8_WAIT_V0; G8_BAR; G8_SCHED;
            if (kt + 3 < nt) G8_STAGE3(1, kt + 3);
            if (kt + 2 < nt) G8_LDF(A0, B0, 0);
            G8_SCHED;
            G8_MMA(A1, B1);
            G8_WAIT_L0; G8_SCHED;
        }
        E(acc, pm, pn, wr, wc, fr, fq);
    }
#undef G8_STAGE1
#undef G8_STAGE3
#undef G8_LDF
#undef G8_MMA
#undef G8_WAIT_V0
#undef G8_WAIT_L0
#undef G8_BAR
#undef G8_SCHED
}
struct EpiG8WResid {
    const float* X; bf16_t* O; int ldc; const float* gate; int gate_bstride; int rows_per_batch; const float* sa; float sa_const; const float* sb;
    __device__ __forceinline__ void operator()(const f32x4 (&acc)[8][4], int pm, int pn, int wr, int wc, int fr_, int fq_) const {
        int fr = fr_, fq = fq_; asm volatile("" : "+v"(fr), "+v"(fq));
        const int row0 = pm * 256 + wr * 128 + fr, colb = pn * 256 + wc * 64 + 8 * fq;
        const float* gp = gate + (size_t)((pm * 256) / rows_per_batch) * gate_bstride + colb;
        f32x4 gv[2][2];
#pragma unroll
        for (int g2 = 0; g2 < 2; ++g2)
#pragma unroll
            for (int q = 0; q < 2; ++q) gv[g2][q] = *(const f32x4*)(gp + 32 * g2 + 4 * q) * *(const f32x4*)(sb + colb + 32 * g2 + 4 * q);
#pragma unroll
        for (int m = 0; m < 8; ++m) { const int row = row0 + 16 * m; const size_t ro = (size_t)row * ldc + colb; const float rs = sa ? sa[row] : sa_const;
#pragma unroll
            for (int g2 = 0; g2 < 2; ++g2) { const f32x4 x0 = *(const f32x4*)(X + ro + 32 * g2), x1 = *(const f32x4*)(X + ro + 32 * g2 + 4);
                const f32x4 v0 = x0 + gv[g2][0] * (acc[m][2 * g2] * rs), v1 = x1 + gv[g2][1] * (acc[m][2 * g2 + 1] * rs);
                u32x4 w; w.x = cvt_pk_bf16(v0[0], v0[1]); w.y = cvt_pk_bf16(v0[2], v0[3]); w.z = cvt_pk_bf16(v1[0], v1[1]); w.w = cvt_pk_bf16(v1[2], v1[3]);
                *(u32x4*)(O + ro + 32 * g2) = w; } }
    }
};
template <class Epi>
__device__ __forceinline__ void gemm8w_phase(PG8_LAS unsigned char* lds, const unsigned char* A, const unsigned char* B, int M, int N, int K, int lda, int ldb, int G, int cidx, const Epi& E) {
    const int tid = threadIdx.x, wid = __builtin_amdgcn_readfirstlane(tid >> 6), lane = tid & 63, wr = wid >> 2, wc = wid & 3, fr = lane & 15, fq = lane >> 4;
    unsigned voffA[2], voffB[2];
#pragma unroll
    for (int i = 0; i < 2; ++i) { int R, C; stage_rc(tid * 16 + i * 8192, R, C); const int Rb = (R & ~31) + perm32(R & 31);
        voffA[i] = (unsigned)(R * lda + 2 * C); voffB[i] = (unsigned)(Rb * ldb + 2 * C); }
    const unsigned ldsw = (unsigned)wid * 1024u;
    const int aoff = wr * HTB + lds_byte(fr, fq * 8), boff = (2 + (wc >> 1)) * HTB + lds_byte(64 * (wc & 1) + fr, fq * 8);
    constexpr int SS = 4 * HTB;
    const int nt = K / 128;
    StaticOrder S; S.init(M, N, G, cidx);
#define G8_STAGE1(bufoff, gptr, voff) do { _Pragma("unroll") for (int _i = 0; _i < 2; ++_i) \
        __builtin_amdgcn_global_load_lds((const unsigned*)((const char*)(gptr) + (voff)[_i]), (PG8_LAS unsigned*)(lds + (bufoff) + ldsw + _i * 8192), 16, 0, 0); } while (0)
#define G8_STAGE4(s, kt) do { const size_t ko_ = (size_t)(kt) * 128; G8_STAGE1((s) * SS, gA + ko_, voffA); G8_STAGE1((s) * SS + HTB, gA + (size_t)128 * lda + ko_, voffA); \
        G8_STAGE1((s) * SS + 2 * HTB, gB + ko_, voffB); G8_STAGE1((s) * SS + 3 * HTB, gB + (size_t)128 * ldb + ko_, voffB); } while (0)
#define G8_STAGE2A(s, kt) do { const size_t ko_ = (size_t)(kt) * 128; G8_STAGE1((s) * SS, gA + ko_, voffA); G8_STAGE1((s) * SS + HTB, gA + (size_t)128 * lda + ko_, voffA); } while (0)
#define G8_STAGE2B(s, kt) do { const size_t ko_ = (size_t)(kt) * 128; G8_STAGE1((s) * SS + 2 * HTB, gB + ko_, voffB); G8_STAGE1((s) * SS + 3 * HTB, gB + (size_t)128 * ldb + ko_, voffB); } while (0)
#define G8_LD4(F, off) do { _Pragma("unroll") for (int q_ = 0; q_ < 4; ++q_) { const bf16x8 l0_ = *(const PG8_LAS bf16x8*)(lds + (off) + q_ * 2048), l1_ = *(const PG8_LAS bf16x8*)(lds + (off) + q_ * 2048 + 1024); F[q_] = cat8(l0_, l1_); } } while (0)
#define G8_MMA4(h) do { __builtin_amdgcn_s_setprio(1); _Pragma("unroll") for (int m = 0; m < 4; ++m) _Pragma("unroll") for (int n = 0; n < 4; ++n) acc[4 * (h) + m][n] = mma_f8(FB[n], FA[m], acc[4 * (h) + m][n]); __builtin_amdgcn_s_setprio(0); } while (0)
#define G8_WAIT_V0 asm volatile("s_waitcnt vmcnt(0)" ::: "memory")
#define G8_WAIT_L0 asm volatile("s_waitcnt lgkmcnt(0)" ::: "memory")
#define G8_BAR __builtin_amdgcn_s_barrier()
#define G8_SCHED __builtin_amdgcn_sched_barrier(0)
    for (int ui = 0;; ++ui) {
        Unit u; if (!S.next(ui, u)) break;
        const char* gA = (const char*)A + (size_t)u.pm * 256 * lda; const char* gB = (const char*)B + (size_t)u.pn * 256 * ldb;
        f32x4 acc[8][4];
#pragma unroll
        for (int m = 0; m < 8; ++m)
#pragma unroll
            for (int n = 0; n < 4; ++n) acc[m][n] = (f32x4){0.f, 0.f, 0.f, 0.f};
        i32x8_t FA[4], FB[4];
        G8_BAR;
        G8_STAGE4(0, 0);
#define G8W_STEP(s, kt_) do { \
            G8_WAIT_V0; G8_BAR; G8_SCHED;                               \
            if ((kt_) + 1 < nt) G8_STAGE2B(1 - (s), (kt_) + 1); \
            G8_LD4(FB, (s) * SS + boff); G8_LD4(FA, (s) * SS + aoff); G8_WAIT_L0; G8_SCHED; \
            G8_MMA4(0); G8_SCHED; \
            if ((kt_) + 1 < nt) G8_STAGE2A(1 - (s), (kt_) + 1);         \
            G8_SCHED; \
            G8_LD4(FA, (s) * SS + aoff + 4 * 2048); G8_WAIT_L0; G8_SCHED; \
            G8_MMA4(1); G8_SCHED; } while (0)
        for (int kt = 0; kt < nt; kt += 2) { G8W_STEP(0, kt); G8W_STEP(1, kt + 1); }
#undef G8W_STEP
        E(acc, u.pm, u.pn, wr, wc, fr, fq);
    }
#undef G8_STAGE1
#undef G8_STAGE4
#undef G8_STAGE2A
#undef G8_STAGE2B
#undef G8_LD4
#undef G8_MMA4
#undef G8_WAIT_V0
#undef G8_WAIT_L0
#undef G8_BAR
#undef G8_SCHED
}
}
constexpr int NWAVES = 8;
constexpr int BATCH = 4, SEQ = 4096, D = 4096, M = BATCH * SEQ;
constexpr int DATTN = 2048, DPOOL = 2048, HD = 128, NH = 16, NPROJ = 3 * DATTN + DPOOL;
constexpr int NGRP = 4, PGRP = 512;
constexpr int MODW = 6 * D;
constexpr int PH = 8, PK = 16, NKEYS = 128, NEXP = NKEYS * NKEYS, PDQ = 256, PDH = 128, NQ = PH * PDQ;
constexpr float EPS = 1e-6f;
constexpr int NPHASE = 13;
constexpr int NSLU = 16;
constexpr int NSL = 32, SLB = 128;
#ifndef MK_N_LAUNCHES
#define MK_N_LAUNCHES 1
#endif
constexpr int N_LAUNCHES = MK_N_LAUNCHES;

constexpr size_t MiB = 1u << 20;
constexpr size_t WS_CTL = 0, CTL_ZERO_BYTES = 64 * 1024;
constexpr size_t WS_MOD = 1 * MiB;
constexpr size_t WS_SK = 2 * MiB;
constexpr size_t WS_WPT = 3 * MiB;
constexpr size_t WS_IDX = 8 * MiB, WS_GW = 16 * MiB;
constexpr int LDK = D + 128;
constexpr size_t WS_WQT = 32 * MiB, WS_WOUTT = 50 * MiB, WS_WINT = 84 * MiB;
constexpr size_t WS_H = 152 * MiB;
constexpr size_t WS_PROJ = 288 * MiB;
constexpr size_t WS_CAT = 544 * MiB;
constexpr size_t WS_DP = 678 * MiB;
constexpr int LDP = DPOOL + 128;
constexpr size_t WS_QP = 742 * MiB;
constexpr size_t WS_X1 = 806 * MiB;
constexpr size_t WS_CAT8 = 936 * MiB, WS_WMIX8 = 1000 * MiB, WS_SCA = 1016 * MiB, WS_SCB = 1017 * MiB;
constexpr size_t WS_U8 = 1056 * MiB, WS_V8 = 1120 * MiB;
constexpr size_t WS_SU = 1184 * MiB, WS_SV = 1185 * MiB;
constexpr size_t WS_H8 = 1186 * MiB;
constexpr size_t WS_SH = 1250 * MiB;
constexpr size_t WS_ACT = 1251 * MiB;
constexpr size_t WS_SSQ = 1259 * MiB;
constexpr size_t WS_PD = WS_PROJ;
constexpr size_t WS_Z = WS_CAT;
constexpr size_t WS_END = 1261 * MiB;
constexpr int CW_TMO = 0, CW_CODE = 1, CW_BAR = 4096;
constexpr int RING_OFF = 0, RING_BYTES = 131072;
constexpr int LDSCTL_OFF = RING_BYTES, MISC_OFF = LDSCTL_OFF + 320;
constexpr int LDS_BYTES = 147456;
static_assert(MISC_OFF + 128 <= LDS_BYTES, "LDS map");
#define GAS __attribute__((address_space(1)))
#define LAS __attribute__((address_space(3)))
typedef unsigned short bf16;
typedef unsigned v4u __attribute__((ext_vector_type(4)));
typedef float f32x4 __attribute__((ext_vector_type(4)));
typedef short bf16x8 __attribute__((ext_vector_type(8)));
typedef GAS unsigned gu32;
typedef GAS unsigned long long gu64;
#define RLX_AGENT __ATOMIC_RELAXED, __HIP_MEMORY_SCOPE_AGENT
#define LDS_WAIT() asm volatile("s_waitcnt lgkmcnt(0)" ::: "memory")
#define VM_WAIT() asm volatile("s_waitcnt vmcnt(0)" ::: "memory")
__device__ __forceinline__ unsigned long long rt() { return __builtin_amdgcn_s_memrealtime(); }
__device__ __forceinline__ unsigned f2bf(float f) { unsigned u = __builtin_bit_cast(unsigned, f); return (u + 0x7fffu + ((u >> 16) & 1u)) >> 16; }
__device__ __forceinline__ unsigned pk2(float lo, float hi) { return f2bf(lo) | (f2bf(hi) << 16); }

#define XB_TMO      128
#define XB_XCNT(j)  (256  + 64 * (j))
#define XB_XSUB(j)  (1280 + 64 * (j))
#define XB_XGEN(j)  (2304 + 64 * (j))
#define XB_TOP      3328
#define XB_TOPGEN   3392
#define XCD_BAR_WORDS 3456
#define XB_SPIN_CAP (1u << 18)

__device__ __forceinline__ unsigned xb_ld(unsigned* p)              { return __hip_atomic_load(p, __ATOMIC_RELAXED, __HIP_MEMORY_SCOPE_AGENT); }
__device__ __forceinline__ unsigned xb_add(unsigned* p, unsigned v) { return __hip_atomic_fetch_add(p, v, __ATOMIC_RELAXED, __HIP_MEMORY_SCOPE_AGENT); }
__device__ __forceinline__ unsigned xb_xcc_id() { return (unsigned)__builtin_amdgcn_s_getreg((3 << 11) | 20) & 0xFu; }
#define XB_SPIN(cond, bar) do { unsigned _sp = 0; while (cond) { __builtin_amdgcn_s_sleep(1); \
    if ((++_sp & 255u) == 0u) { if (xb_ld(&(bar)[XB_TMO])) break; if (_sp > XB_SPIN_CAP) { atomicAdd(&(bar)[XB_TMO], 1u); break; } } } } while (0)

struct XcdBarrier {
    unsigned* bar; unsigned x;
    volatile LAS unsigned* st;
};

__device__ __forceinline__ XcdBarrier xcd_barrier_post(unsigned* bar, volatile LAS unsigned* st) {
    XcdBarrier b; b.bar = bar; b.x = xb_xcc_id(); b.st = st;
    if (threadIdx.x == 0) (void)xb_add(&bar[XB_XCNT(b.x)], 1u);
    return b;
}
__device__ __forceinline__ void xcd_barrier_complete(unsigned* bar, unsigned x, unsigned& nloc, unsigned& nx) {
    const unsigned G = gridDim.x * gridDim.y * gridDim.z;
    unsigned sum, cnt, mine, sp = 0u;
    for (;;) {
        sum = 0u; cnt = 0u; mine = 0u;
#pragma unroll
        for (unsigned j = 0; j < 16; ++j) { const unsigned c = xb_ld(&bar[XB_XCNT(j)]); sum += c; cnt += (c > 0u) ? 1u : 0u; mine = (j == x) ? c : mine; }
        if (sum == G) break;
        __builtin_amdgcn_s_sleep(1);
        if ((++sp & 255u) == 0u) { if (xb_ld(&bar[XB_TMO])) break; if (sp > XB_SPIN_CAP) { atomicAdd(&bar[XB_TMO], 1u); break; } }
    }
    nloc = mine > 0u ? mine : 1u; nx = cnt > 0u ? cnt : 1u;
}

__device__ __forceinline__ void xcd_barrier(const XcdBarrier& b) {
    asm volatile("s_waitcnt vmcnt(0)" ::: "memory");
    __syncthreads();
    if (threadIdx.x == 0) {
        unsigned* bar = b.bar;
        __builtin_amdgcn_s_waitcnt(0);
        unsigned nloc = b.st[0], nx = b.st[1];
        if (nloc == 0u) { xcd_barrier_complete(bar, b.x, nloc, nx); b.st[0] = nloc; b.st[1] = nx; }
        const unsigned old = xb_add(&bar[XB_XSUB(b.x)], 1u);
        const unsigned gen = old / nloc;
        if (old + 1u == (gen + 1u) * nloc) {
            __builtin_amdgcn_fence(__ATOMIC_RELEASE, "agent");
            asm volatile("s_waitcnt vmcnt(0)" ::: "memory");
            const unsigned og = xb_add(&bar[XB_TOP], 1u);
            const unsigned tg = og / nx;
            if (og + 1u == (tg + 1u) * nx) xb_add(&bar[XB_TOPGEN], 1u);
            else XB_SPIN(xb_ld(&bar[XB_TOPGEN]) == tg, bar);
            __builtin_amdgcn_fence(__ATOMIC_ACQUIRE, "agent");
            xb_add(&bar[XB_XGEN(b.x)], 1u);
            asm volatile("s_waitcnt vmcnt(0)" ::: "memory");
        } else {
            XB_SPIN(xb_ld(&bar[XB_XGEN(b.x)]) == gen, bar);
            __builtin_amdgcn_fence(__ATOMIC_ACQUIRE, "agent");
            asm volatile("s_waitcnt vmcnt(0)" ::: "memory");
        }
    }
    __syncthreads();
}
typedef float f32x16 __attribute__((ext_vector_type(16)));
typedef short s16x4 __attribute__((ext_vector_type(4)));
typedef __bf16 bf16v2 __attribute__((ext_vector_type(2)));
typedef float f32x2 __attribute__((ext_vector_type(2)));
typedef int i32x2 __attribute__((ext_vector_type(2)));
#define DI __device__ __forceinline__
#define MFMA32(a, b, c) __builtin_amdgcn_mfma_f32_32x32x16_bf16((a), (b), (c), 0, 0, 0)
DI unsigned pkbf(float lo, float hi) { bf16v2 v = {(__bf16)lo, (__bf16)hi}; return __builtin_bit_cast(unsigned, v); }
DI float bflo(unsigned u) { return __builtin_bit_cast(float, u << 16); }
DI float bfhi(unsigned u) { return __builtin_bit_cast(float, u & 0xffff0000u); }
constexpr float FP4_K2 = 6.f;
constexpr float FP4_TOP = 6.f;
constexpr float FP4_CLIP = 0.8f;
constexpr float CAT_SCALE = 32.f;
DI unsigned pk4_fp8(float a, float b, float c, float d) {
    const float lim = 448.f;
    a = fminf(fmaxf(a * CAT_SCALE, -lim), lim); b = fminf(fmaxf(b * CAT_SCALE, -lim), lim); c = fminf(fmaxf(c * CAT_SCALE, -lim), lim); d = fminf(fmaxf(d * CAT_SCALE, -lim), lim);
    int pk = __builtin_amdgcn_cvt_pk_fp8_f32(a, b, 0, false); pk = __builtin_amdgcn_cvt_pk_fp8_f32(c, d, pk, true); return (unsigned)pk;
}
DI int crow(int reg, int h) { return (reg & 3) + 8 * (reg >> 2) + 4 * h; }
DI float wave_sum(float v) {
#pragma unroll
    for (int o = 1; o < 64; o <<= 1) v += __shfl_xor(v, o);
    return v;
}
struct Frame {
    LAS unsigned char* lds;
    volatile LAS unsigned* MISC;
    gu32* ctl;
    int tid, lane, wave, vcu, G;
    const float *x, *c, *w_ada, *b_ada, *g1, *w_in, *g_ah, *w_pool, *s_pool, *w_out, *g2, *w_query, *sk1, *sk2, *u_exp, *v_exp, *g_final;
    float* out;
    float* MOD; bf16 *SK, *WPS, *WQT, *WMIXT, *WOP, *WINT, *H, *PROJ, *CAT, *QP, *DELTA; unsigned short* IDX; float* GW;
    unsigned char *U8, *V8, *H8, *ACT8, *CAT8, *WMIX8; float *SCA, *SCB; float *SU, *SV, *SH, *SA, *SSQ; bf16 *PD, *Z;
};

struct TpItem { float tv[32]; };
DI void tp_load(const float* W, int N, int item, int lane, TpItem& T) {
    const int nblk = N / 32, kb = item / nblk, nb = item % nblk, k0 = 64 * kb, n0 = 32 * nb;
#pragma unroll
    for (int i = 0; i < 32; ++i) T.tv[i] = W[(size_t)(k0 + 2 * i + (lane >> 5)) * N + n0 + (lane & 31)];
}
DI void tp_store(int N, bf16* WT, int ldt, int row_off, LAS float* scr, int item, int lane, const TpItem& T) {
    const int nblk = N / 32, kb = item / nblk, nb = item % nblk, k0 = 64 * kb, n0 = 32 * nb;
#pragma unroll
    for (int i = 0; i < 32; ++i) scr[(2 * i + (lane >> 5)) * 33 + (lane & 31)] = T.tv[i];
    LDS_WAIT(); asm volatile("" ::: "memory");
    const int c = lane & 7;
#pragma unroll
    for (int j = 0; j < 4; ++j) { const int n = (lane >> 3) + 8 * j; const LAS float* s = scr + (8 * c) * 33 + n;
        v4u o; o.x = pkbf(s[0 * 33], s[1 * 33]); o.y = pkbf(s[2 * 33], s[3 * 33]); o.z = pkbf(s[4 * 33], s[5 * 33]); o.w = pkbf(s[6 * 33], s[7 * 33]);
        *(GAS v4u*)(WT + (size_t)(row_off + n0 + n) * ldt + k0 + 8 * c) = o; }
    LDS_WAIT(); asm volatile("" ::: "memory");
}
struct TpDesc { const float* W; int N; bf16* WT; int ldt; int item; };
DI TpDesc tp_desc(const Frame& F, int it) {
    constexpr int I_IN = (D / 64) * (NPROJ / 32), I_OUT = (D / 64) * (D / 32);
    TpDesc d;
    if (it < I_IN) { d.W = F.w_in; d.N = NPROJ; d.WT = F.WINT; d.ldt = LDK; d.item = it; return d; }
    it -= I_IN;
    if (it < I_OUT) { const int kb = it / (D / 32); d.W = F.w_out; d.N = D; d.item = it;
        if (kb < DATTN / 64) { d.WT = F.WMIXT; d.ldt = LDK; } else { d.WT = F.WOP - DATTN; d.ldt = LDP; }
        return d; }
    it -= I_OUT; d.W = F.w_query; d.N = NQ; d.WT = F.WQT; d.ldt = LDK; d.item = it; return d;
}
DI unsigned fp4_code(float x) {
    const float m = __builtin_fabsf(x);
    const unsigned c = (unsigned)(m >= 0.25f) + (unsigned)(m >= 0.75f) + (unsigned)(m >= 1.25f) + (unsigned)(m >= 1.75f) + (unsigned)(m >= 2.5f) + (unsigned)(m >= 3.5f) + (unsigned)(m >= 5.0f);
    return c | (x < 0.f ? 8u : 0u);
}
DI float fp4_val(unsigned c) {
    const unsigned e = (c >> 1) & 3u, mbit = c & 1u;
    const float mag = e == 0u ? 0.5f * (float)mbit : (float)(1u << (e - 1u)) * (1.f + 0.5f * (float)mbit);
    return (c & 8u) ? -mag : mag;
}
DI unsigned fp4_pack4(float a, float b, float c, float d) { unsigned r = 0; r = __builtin_amdgcn_cvt_scalef32_pk_fp4_f32(r, a, b, 1.0f, 0); r = __builtin_amdgcn_cvt_scalef32_pk_fp4_f32(r, c, d, 1.0f, 1); return r; }
DI void fp4_planes4(float e0, float e1, float e2, float e3, unsigned& p0, unsigned& p1) {
    p0 = fp4_pack4(e0, e1, e2, e3);
    const f32x2 va = __builtin_amdgcn_cvt_scalef32_pk_f32_fp4(p0, 1.0f, 0), vb = __builtin_amdgcn_cvt_scalef32_pk_f32_fp4(p0, 1.0f, 1);
    p1 = fp4_pack4((e0 - va.x) * FP4_K2, (e1 - va.y) * FP4_K2, (e2 - vb.x) * FP4_K2, (e3 - vb.y) * FP4_K2);
}
DI void conv_row_fp4(const float* src, unsigned char* tab, int e, float* scale_out, int lane) {
    const GAS f32x4* p = (const GAS f32x4*)src + lane;
    f32x4 v[16]; float am = 0.f;
#pragma unroll
    for (int j = 0; j < 16; ++j) { v[j] = p[64 * j]; am = fmaxf(fmaxf(am, fmaxf(__builtin_fabsf(v[j].x), __builtin_fabsf(v[j].y))), fmaxf(__builtin_fabsf(v[j].z), __builtin_fabsf(v[j].w))); }
#pragma unroll
    for (int o = 1; o < 64; o <<= 1) am = fmaxf(am, __shfl_xor(am, o));
    const float sc = am > 1e-30f ? am * (FP4_CLIP / FP4_TOP) : 1.f, inv = am > 1e-30f ? FP4_TOP / (FP4_CLIP * am) : 0.f;
#pragma unroll
    for (int j = 0; j < 16; ++j) {
        const unsigned pk = fp4_pack4(v[j].x * inv, v[j].y * inv, v[j].z * inv, v[j].w * inv);
        *(GAS unsigned short*)(tab + ((size_t)j * NEXP + e) * SLB + 2 * lane) = (unsigned short)pk; }
    if (lane == 0) *scale_out = sc;
}
DI void ph0_prologue(Frame& F) {
    LAS float* sc = (LAS float*)(F.lds + RING_OFF);
    LAS float* red = (LAS float*)(F.lds + RING_OFF + 65536);
    for (int i = F.tid; i < BATCH * D; i += NWAVES * 64) { const float cv = F.c[i]; sc[i] = cv / (1.f + __expf(-cv)); }
    __syncthreads();
    const int cq = F.tid % 24, rl = F.tid / 24;
#ifdef PROBE_P0A
    for (int rep_ = 0; rep_ < 2; ++rep_)
#endif
    for (int cc = F.vcu; cc < MODW / 96; cc += F.G) {
        if (rl < 21) {
            f32x4 a0 = {0.f, 0.f, 0.f, 0.f}, a1 = a0, a2 = a0, a3 = a0;
            const float* wp = F.w_ada + (size_t)rl * MODW + 96 * cc + 4 * cq;
#pragma unroll 13
            for (int d = rl; d < D; d += 21) { const f32x4 w = *(const GAS f32x4*)wp; wp += (size_t)21 * MODW;
                a0 += sc[d] * w; a1 += sc[D + d] * w; a2 += sc[2 * D + d] * w; a3 += sc[3 * D + d] * w; }
            LAS f32x4* rp = (LAS f32x4*)(red + (rl * 24 + cq) * 16); rp[0] = a0; rp[1] = a1; rp[2] = a2; rp[3] = a3;
        }
        __syncthreads();
        if (F.tid < 384) { const int q = F.tid >> 4, e = F.tid & 15; float s = 0.f;
            for (int r2 = 0; r2 < 21; ++r2) s += red[(r2 * 24 + q) * 16 + e];
            const int col = 96 * cc + 4 * q + (e & 3); F.MOD[(e >> 2) * MODW + col] = s + F.b_ada[col]; }
        __syncthreads();
    }
    LAS float* scr = (LAS float*)(F.lds + RING_OFF + F.wave * 16384);
    const int gw = F.vcu * NWAVES + F.wave, NGW = F.G * NWAVES;
    constexpr int I_IN = (D / 64) * (NPROJ / 32), I_OUT = (D / 64) * (D / 32), I_Q = (D / 64) * (NQ / 32), I_P1 = (PGRP / 64) * (PGRP / 32);
    constexpr int NITEMS = I_IN + I_OUT + I_Q;
    {
        TpItem Ta, Tb; int it = gw;
        if (it < NITEMS) { { const TpDesc d0 = tp_desc(F, it); tp_load(d0.W, d0.N, d0.item, F.lane, Ta); }
            while (true) {
                const int i1 = it + NGW; const bool h1 = i1 < NITEMS;
                if (h1) { const TpDesc d1 = tp_desc(F, i1); tp_load(d1.W, d1.N, d1.item, F.lane, Tb); }
                { const TpDesc dc = tp_desc(F, it); tp_store(dc.N, dc.WT, dc.ldt, 0, scr, dc.item, F.lane, Ta); }
                if (!h1) break;
                const int i2 = i1 + NGW; const bool h2 = i2 < NITEMS;
                if (h2) { const TpDesc d2 = tp_desc(F, i2); tp_load(d2.W, d2.N, d2.item, F.lane, Ta); }
                { const TpDesc dc = tp_desc(F, i1); tp_store(dc.N, dc.WT, dc.ldt, 0, scr, dc.item, F.lane, Tb); }
                if (!h2) break;
                it = i2; } } }
    for (int i = F.vcu * NWAVES * 64 + F.tid; i < NGRP * PGRP * PGRP / 4; i += F.G * NWAVES * 64) {
        const f32x4 w = ((const GAS f32x4*)F.w_pool)[i]; const int e0 = 4 * i, g = e0 / (PGRP * PGRP), d0 = e0 % PGRP;
        const f32x4 sp = *(const GAS f32x4*)(F.s_pool + g * PGRP + d0);
        ((GAS unsigned long long*)F.WPS)[i] = (unsigned long long)pkbf(w.x * sp.x, w.y * sp.y) | ((unsigned long long)pkbf(w.z * sp.z, w.w * sp.w) << 32);
    }
#ifdef PROBE_P0D
    for (int rep_ = 0; rep_ < 2; ++rep_)
#endif
    for (int row = gw; row < 2 * NEXP; row += NGW) {
        if (row < NEXP) conv_row_fp4(F.u_exp + (size_t)row * D, F.U8, row, F.SU + row, F.lane);
        else { const int e = row - NEXP; conv_row_fp4(F.v_exp + (size_t)e * D, F.V8, e, F.SV + e, F.lane); }
    }
    for (int i = F.vcu * NWAVES * 64 + F.tid; i < NKEYS * PDH; i += F.G * NWAVES * 64) {
        const float* src = (i < NKEYS * PDH / 2) ? F.sk1 + 2 * i : F.sk2 + 2 * (i - NKEYS * PDH / 2);
        ((GAS unsigned*)F.SK)[i] = pkbf(src[0], src[1]);
    }
}

template <bool FP8> struct NRaw { f32x4 r[16]; };
template <> struct NRaw<true> { unsigned long long r[16]; };
template <bool FP8> DI void norm_load(Frame& F, const float* src, int m, NRaw<FP8>& R) {
    if constexpr (!FP8) { const GAS f32x4* xr = (const GAS f32x4*)(src + (size_t)m * D) + F.lane;
#pragma unroll
        for (int j = 0; j < 16; ++j) R.r[j] = xr[64 * j];
    } else {
        const GAS unsigned long long* dr = (const GAS unsigned long long*)(F.DELTA + (size_t)m * D) + F.lane;
#pragma unroll
        for (int j = 0; j < 16; ++j) R.r[j] = dr[64 * j];
    }
}
template <bool FP8> DI void norm_row(Frame& F, LAS float* A1, LAS float* S1, int m, const NRaw<FP8>& R, bf16* dst) {
    f32x4 v[16]; float ss = 0.f;
#pragma unroll
    for (int j = 0; j < 16; ++j) {
        if constexpr (!FP8) v[j] = R.r[j];
        else { const unsigned long long q = R.r[j]; const unsigned lo = (unsigned)q, hi = (unsigned)(q >> 32); v[j].x = bflo(lo); v[j].y = bfhi(lo); v[j].z = bflo(hi); v[j].w = bfhi(hi); }
    }
#pragma unroll
    for (int j = 0; j < 16; ++j) ss += (v[j].x * v[j].x + v[j].y * v[j].y) + (v[j].z * v[j].z + v[j].w * v[j].w);
    const float rstd = 1.f / sqrtf(wave_sum(ss) * (1.f / D) + EPS);
    GAS unsigned long long* o8 = (GAS unsigned long long*)(dst + (size_t)m * LDK) + F.lane;
#pragma unroll
    for (int j = 0; j < 16; ++j) { const f32x4 a = *(const LAS f32x4*)(A1 + 4 * F.lane + 256 * j), s = *(const LAS f32x4*)(S1 + 4 * F.lane + 256 * j);
        const f32x4 o = v[j] * rstd * a + s; v[j] = o;
        o8[64 * j] = (unsigned long long)pkbf(o.x, o.y) | ((unsigned long long)pkbf(o.z, o.w) << 32);
        if ((j & 3) == 3) __builtin_amdgcn_sched_barrier(0); }
    if constexpr (FP8) {
        float am = 0.f;
#pragma unroll
        for (int j = 0; j < 16; ++j) am = fmaxf(fmaxf(am, fmaxf(__builtin_fabsf(v[j].x), __builtin_fabsf(v[j].y))), fmaxf(__builtin_fabsf(v[j].z), __builtin_fabsf(v[j].w)));
#pragma unroll
        for (int o = 1; o < 64; o <<= 1) am = fmaxf(am, __shfl_xor(am, o));
        const float sc = am > 1e-30f ? am * (1.f / FP4_TOP) : 1.f, inv = am > 1e-30f ? FP4_TOP / am : 0.f;
        GAS unsigned char* d4 = (GAS unsigned char*)(F.H8 + (size_t)m * D);
#pragma unroll
        for (int j = 0; j < 16; ++j) { const float e0 = v[j].x * inv, e1 = v[j].y * inv, e2 = v[j].z * inv, e3 = v[j].w * inv;
            unsigned q0, q1; fp4_planes4(e0, e1, e2, e3, q0, q1);
            *(GAS unsigned short*)(d4 + 128 * j + 2 * F.lane) = (unsigned short)q0;
            *(GAS unsigned short*)(d4 + 2048 + 128 * j + 2 * F.lane) = (unsigned short)q1; }
        if (F.lane == 0) F.SH[m] = sc;
    }
}
template <bool FP8> DI void norm_phase(Frame& F, const float* src, const float* gain, int kshift, int kscale, bf16* dst) {
    LAS float* A1 = (LAS float*)(F.lds + RING_OFF);
    LAS float* S1 = A1 + D;
    for (int rt = F.vcu; rt < M / 64; rt += F.G) {
        const int b = (rt * 64) / SEQ, m0 = rt * 64 + F.wave * 8;
        NRaw<FP8> Ra, Rb;
        norm_load<FP8>(F, src, m0, Ra);
        __syncthreads();
        for (int i = F.tid; i < D; i += NWAVES * 64) { A1[i] = gain[i] * (1.f + F.MOD[b * MODW + kscale * D + i]); S1[i] = F.MOD[b * MODW + kshift * D + i]; }
        __syncthreads();
        for (int i = 0; i < 8; i += 2) {
            norm_load<FP8>(F, src, m0 + i + 1, Rb);
            norm_row<FP8>(F, A1, S1, m0 + i, Ra, dst);
            if (i + 2 < 8) norm_load<FP8>(F, src, m0 + i + 2, Ra);
            norm_row<FP8>(F, A1, S1, m0 + i + 1, Rb, dst);
        }
    }
}

template <int G> DI void pool_diff_group(Frame& F) {
    constexpr int W = 2 << G, NR = W + 3;
    const int gt = F.vcu * NWAVES * 64 + F.tid, NT = F.G * NWAVES * 64;
    for (int it = gt; it < (M / 4) * (PGRP / 8); it += NT) {
        const int m0 = (it >> 6) * 4, ci = it & 63, pos0 = m0 & (SEQ - 1);
        const bf16* p = F.PROJ + (size_t)3 * M * DATTN + (size_t)m0 * DPOOL + G * PGRP + ci * 8;
        v4u v[NR];
#pragma unroll
        for (int k = 0; k < NR; ++k) { const int back = (W - 1) - k; v[k] = *(const GAS v4u*)(p - (ptrdiff_t)((back > 0 && back <= pos0) ? back : (back > 0 ? 0 : back)) * DPOOL); }
        float s[8];
#pragma unroll
        for (int q = 0; q < 8; ++q) s[q] = 0.f;
#pragma unroll
        for (int k = 0; k < W; ++k) { const float wg = ((W - 1) - k <= pos0) ? 1.f : 0.f;
            s[0] += wg * bflo(v[k].x); s[1] += wg * bfhi(v[k].x); s[2] += wg * bflo(v[k].y); s[3] += wg * bfhi(v[k].y); s[4] += wg * bflo(v[k].z); s[5] += wg * bfhi(v[k].z); s[6] += wg * bflo(v[k].w); s[7] += wg * bfhi(v[k].w); }
#pragma unroll
        for (int j = 0; j < 4; ++j) {
            if (j > 0) { const float wo = ((W - 1) - (j - 1) <= pos0) ? 1.f : 0.f;
                const v4u a = v[j + W - 1], d = v[j - 1];
                s[0] += bflo(a.x) - wo * bflo(d.x); s[1] += bfhi(a.x) - wo * bfhi(d.x); s[2] += bflo(a.y) - wo * bflo(d.y); s[3] += bfhi(a.y) - wo * bfhi(d.y);
                s[4] += bflo(a.z) - wo * bflo(d.z); s[5] += bfhi(a.z) - wo * bfhi(d.z); s[6] += bflo(a.w) - wo * bflo(d.w); s[7] += bfhi(a.w) - wo * bfhi(d.w); }
            const int cnt = (pos0 + j + 1 < W) ? pos0 + j + 1 : W; const float inv = 1.f / (float)cnt; const v4u cur = v[j + W - 1];
            const unsigned o0 = pk4_fp8(s[0] * inv - bflo(cur.x), s[1] * inv - bfhi(cur.x), s[2] * inv - bflo(cur.y), s[3] * inv - bfhi(cur.y));
            const unsigned o1 = pk4_fp8(s[4] * inv - bflo(cur.z), s[5] * inv - bfhi(cur.z), s[6] * inv - bflo(cur.w), s[7] * inv - bfhi(cur.w));
            *(GAS unsigned long long*)(F.CAT8 + (size_t)(m0 + j) * D + DATTN + G * PGRP + ci * 8) = (unsigned long long)o0 | ((unsigned long long)o1 << 32);
        }
    }
}
DI void pool_diff_phase(Frame& F) { pool_diff_group<0>(F); pool_diff_group<1>(F); pool_diff_group<2>(F); pool_diff_group<3>(F); }

DI void conv_bf16_row_fp8(const bf16* src, unsigned char* dst, float* scale_out, int lane) {
    const GAS unsigned long long* p = (const GAS unsigned long long*)src + lane;
    f32x4 v[16]; float am = 0.f;
#pragma unroll
    for (int j = 0; j < 16; ++j) { const unsigned long long q = p[64 * j]; const unsigned lo = (unsigned)q, hi = (unsigned)(q >> 32);
        v[j].x = bflo(lo); v[j].y = bfhi(lo); v[j].z = bflo(hi); v[j].w = bfhi(hi);
        am = fmaxf(fmaxf(am, fmaxf(__builtin_fabsf(v[j].x), __builtin_fabsf(v[j].y))), fmaxf(__builtin_fabsf(v[j].z), __builtin_fabsf(v[j].w))); }
#pragma unroll
    for (int o = 1; o < 64; o <<= 1) am = fmaxf(am, __shfl_xor(am, o));
    const float sc = am > 1e-30f ? am * (1.f / 448.f) : 1.f, inv = am > 1e-30f ? 448.f / am : 0.f;
    GAS unsigned* d = (GAS unsigned*)dst + lane;
#pragma unroll
    for (int j = 0; j < 16; ++j) { int pk = __builtin_amdgcn_cvt_pk_fp8_f32(v[j].x * inv, v[j].y * inv, 0, false); pk = __builtin_amdgcn_cvt_pk_fp8_f32(v[j].z * inv, v[j].w * inv, pk, true); d[64 * j] = (unsigned)pk; }
    if (lane == 0) *scale_out = sc;
}
DI void mix_weight_fp8(Frame& F) {
    const int gw = F.vcu * NWAVES + F.wave, NGW = F.G * NWAVES;
    for (int n = gw; n < D; n += NGW) { int ln = F.lane; asm volatile("" : "+v"(ln)); conv_bf16_row_fp8(F.WMIXT + (size_t)n * LDK, F.WMIX8 + (size_t)n * D, F.SCB + n, ln); }
}

constexpr int KT_OFF = 0, VT_OFF = 8192;
DI void attn_dma_tile(LAS unsigned char* dst, const bf16* src, const unsigned (&dv)[4]) {
#pragma unroll
    for (int i = 0; i < 8; ++i)
        __builtin_amdgcn_global_load_lds((const unsigned*)((const char*)src + dv[i & 3] + i * 1024), (LAS unsigned*)(dst + i * 1024), 16, 0, 0);
}
template <bool DIAG> DI void attn_block(LAS unsigned char* wl, const bf16* knext, const bf16* vnext, const unsigned (&dv)[4], const bf16x8 (&qf)[8], f32x16 (&o)[4], float& R, int lane, int r, int hh, unsigned trE, unsigned trO) {
    const float SC = 0.08838834764831845f * 1.4426950408889634f;
    asm volatile("s_waitcnt vmcnt(8)" ::: "memory");
    bf16x8 kf[8];
#pragma unroll
    for (int ks = 0; ks < 8; ++ks) kf[ks] = *(const LAS bf16x8*)(wl + KT_OFF + r * 256 + (((2 * ks + hh) ^ (r & 15)) << 4));
    asm volatile("s_waitcnt lgkmcnt(0)" ::: "memory");
    __builtin_amdgcn_sched_barrier(0);
    attn_dma_tile(wl + KT_OFF, knext, dv);
    __builtin_amdgcn_sched_barrier(0);
    f32x16 s;
#pragma unroll
    for (int i = 0; i < 16; ++i) s[i] = 0.f;
#pragma unroll
    for (int ks = 0; ks < 8; ++ks) s = MFMA32(kf[ks], qf[ks], s);
    float zz[16], sp[16], ln[16];
#pragma unroll
    for (int i = 0; i < 16; ++i) {
        zz[i] = s[i] * SC;
        const float e = __builtin_amdgcn_exp2f(-__builtin_fabsf(zz[i]));
        sp[i] = fmaxf(zz[i], 0.f) + __builtin_amdgcn_logf(1.f + e);
        const bool valid = !DIAG || (crow(i, hh) < r);
        ln[i] = valid ? -sp[i] : 0.f;
    }
    float Gs[4], Ps[4];
#pragma unroll
    for (int g = 0; g < 4; ++g) Gs[g] = (ln[4 * g] + ln[4 * g + 1]) + (ln[4 * g + 2] + ln[4 * g + 3]);
#pragma unroll
    for (int g = 0; g < 4; ++g) Ps[g] = __shfl_xor(Gs[g], 32);
    float later[4];
    later[3] = 0.f; later[2] = Gs[3] + Ps[3]; later[1] = later[2] + (Gs[2] + Ps[2]); later[0] = later[1] + (Gs[1] + Ps[1]);
    const float T = later[0] + (Gs[0] + Ps[0]);
    float a[16];
#pragma unroll
    for (int g = 0; g < 4; ++g) {
        const float bg = R + later[g] + ((hh == 0) ? Ps[g] : 0.f);
        const float w2 = ln[4 * g + 3], w1 = w2 + ln[4 * g + 2], w0 = w1 + ln[4 * g + 1];
        const float wv[4] = {w0, w1, w2, 0.f};
#pragma unroll
        for (int rr = 0; rr < 4; ++rr) { const int i = 4 * g + rr;
            const bool valid = !DIAG || (crow(i, hh) < r);
            const float ex = __builtin_amdgcn_exp2f((zz[i] - sp[i]) + (bg + wv[rr]));
            a[i] = valid ? ex : 0.f; }
    }
    R += T;
    v4u x0, x1;
    x0.x = pkbf(a[0], a[1]); x0.y = pkbf(a[2], a[3]); x0.z = pkbf(a[4], a[5]); x0.w = pkbf(a[6], a[7]);
    x1.x = pkbf(a[8], a[9]); x1.y = pkbf(a[10], a[11]); x1.z = pkbf(a[12], a[13]); x1.w = pkbf(a[14], a[15]);
    const bf16x8 xs0 = __builtin_bit_cast(bf16x8, x0), xs1 = __builtin_bit_cast(bf16x8, x1);
    asm volatile("s_waitcnt vmcnt(8)" ::: "memory");
    __builtin_amdgcn_sched_barrier(0);
#pragma unroll
    for (int c = 0; c < 4; ++c) {
        const unsigned ta = VT_OFF + ((c & 1) ? trO : trE) + 64 * (c & 1);
        const s16x4 l0 = __builtin_amdgcn_ds_read_tr16_b64_v4i16((LAS s16x4*)(wl + ta + 128 * (c >> 1)));
        const s16x4 h0 = __builtin_amdgcn_ds_read_tr16_b64_v4i16((LAS s16x4*)(wl + ta + 8 * 256 + 128 * ((c >> 1) ^ 1)));
        const s16x4 l1 = __builtin_amdgcn_ds_read_tr16_b64_v4i16((LAS s16x4*)(wl + ta + 16 * 256 + 128 * (c >> 1)));
        const s16x4 h1 = __builtin_amdgcn_ds_read_tr16_b64_v4i16((LAS s16x4*)(wl + ta + 24 * 256 + 128 * ((c >> 1) ^ 1)));
        const bf16x8 vf0 = __builtin_shufflevector(l0, h0, 0, 1, 2, 3, 4, 5, 6, 7), vf1 = __builtin_shufflevector(l1, h1, 0, 1, 2, 3, 4, 5, 6, 7);
        o[c] = MFMA32(vf0, xs0, o[c]);
        o[c] = MFMA32(vf1, xs1, o[c]);
    }
    asm volatile("s_waitcnt lgkmcnt(0)" ::: "memory");
    __builtin_amdgcn_sched_barrier(0);
    attn_dma_tile(wl + VT_OFF, vnext, dv);
    __builtin_amdgcn_sched_barrier(0);
}
DI void attn_task(Frame& F, LAS unsigned char* wl, int bh, int qt) {
    const int lane = F.lane, r = lane & 31, hh = lane >> 5;
    const int b = bh >> 4, h = bh & 15, t0 = 32 * qt;
    const bf16* qb = F.PROJ + (size_t)bh * SEQ * HD, *kb_ = qb + (size_t)M * DATTN, *vb = kb_ + (size_t)M * DATTN;
    bf16x8 qf[8];
    { const bf16* qp = qb + (size_t)(t0 + r) * HD + 8 * hh;
#pragma unroll
      for (int ks = 0; ks < 8; ++ks) qf[ks] = *(const GAS bf16x8*)(qp + 16 * ks); }
    unsigned dv[4];
    { const int q4 = lane >> 4, g0 = (lane & 15) ^ q4;
#pragma unroll
      for (int m = 0; m < 4; ++m) dv[m] = (unsigned)(q4 * 256 + 16 * (g0 ^ (4 * m))); }
    attn_dma_tile(wl + KT_OFF, kb_ + (size_t)t0 * HD, dv);
    attn_dma_tile(wl + VT_OFF, vb + (size_t)t0 * HD, dv);
    f32x16 o[4];
#pragma unroll
    for (int c = 0; c < 4; ++c)
#pragma unroll
        for (int i = 0; i < 16; ++i) o[c][i] = 0.f;
    float R = 0.f;
    const int L16 = lane & 15, trq = L16 >> 2, trp = L16 & 3, blk = (lane >> 4) & 1;
    const unsigned trb = (unsigned)((4 * hh + trq) * 256 + ((((2 * blk + (trp >> 1)) ^ trq)) << 4) + 8 * (trp & 1));
    const unsigned trE = trb + 64 * hh, trO = trb - 64 * hh;
    for (int kb = qt; kb >= 0; --kb) {
        const size_t sn = (size_t)32 * (kb > 0 ? kb - 1 : 0) * HD;
        if (kb == qt) attn_block<true>(wl, kb_ + sn, vb + sn, dv, qf, o, R, lane, r, hh, trE, trO);
        else attn_block<false>(wl, kb_ + sn, vb + sn, dv, qf, o, R, lane, r, hh, trE, trO);
        if (__all(R < -152.f)) break;
    }
    asm volatile("s_waitcnt vmcnt(0)" ::: "memory");
    float ss = 0.f;
#pragma unroll
    for (int c = 0; c < 4; ++c)
#pragma unroll
        for (int i = 0; i < 16; ++i) ss += o[c][i] * o[c][i];
    ss += __shfl_xor(ss, 32);
    const float rstd = 1.f / sqrtf(ss * (1.f / HD) + EPS);
    const float* gp = F.g_ah + h * HD;
    int lq = lane; asm volatile("" : "+v"(lq));
    const int rq = lq & 31, hq = lq >> 5;
    constexpr int OP = 144;
#pragma unroll
    for (int c = 0; c < 4; ++c)
#pragma unroll
        for (int g = 0; g < 4; ++g) { const int d0 = 32 * c + 8 * g + 4 * hq; const f32x4 gv = *(const GAS f32x4*)(gp + d0);
            *(LAS unsigned*)(wl + rq * OP + d0) = pk4_fp8(o[c][4 * g] * rstd * gv.x, o[c][4 * g + 1] * rstd * gv.y, o[c][4 * g + 2] * rstd * gv.z, o[c][4 * g + 3] * rstd * gv.w); }
    unsigned char* obase = F.CAT8 + (size_t)(b * SEQ + t0) * D + h * HD;
#pragma unroll
    for (int j = 0; j < 4; ++j) { const int row = 8 * j + (lq >> 3), ch = lq & 7;
        *(GAS v4u*)(obase + (size_t)row * D + 16 * ch) = *(const LAS v4u*)(wl + row * OP + 16 * ch); }
}
DI void attn_phase(Frame& F) {
    LAS unsigned char* wl = F.lds + RING_OFF + F.wave * 16384;
    const int gw = F.vcu * NWAVES + F.wave, NGW = F.G * NWAVES;
    for (int wt = gw; wt < BATCH * NH * (SEQ / 32); wt += NGW) attn_task(F, wl, wt >> 7, wt & 127);
}
DI int f2key(float f) { const int b = __builtin_bit_cast(int, f); return b ^ ((b >> 31) & 0x7fffffff); }
DI float key2f(int k) { const int b = k ^ ((k >> 31) & 0x7fffffff); return __builtin_bit_cast(float, b); }
DI void ce_desc(int& a, int& b) { const int hi = a > b ? a : b, lo = a > b ? b : a; a = hi; b = lo; }
DI int imax(int a, int b) { return a > b ? a : b; }
DI void sort16_desc(int (&v)[16]) {
#pragma unroll
    for (int k = 2; k <= 16; k <<= 1)
#pragma unroll
        for (int j = k >> 1; j > 0; j >>= 1)
#pragma unroll
            for (int i = 0; i < 16; ++i) { const int l = i ^ j; if (l > i) { if ((i & k) == 0) ce_desc(v[i], v[l]); else ce_desc(v[l], v[i]); } }
}
DI void bitonic_merge16_desc(int (&v)[16]) {
#pragma unroll
    for (int j = 8; j > 0; j >>= 1)
#pragma unroll
        for (int i = 0; i < 16; ++i) { const int l = i ^ j; if (l > i) ce_desc(v[i], v[l]); }
}
DI void merge_top16(int (&A)[16], const int (&B)[16]) {
#pragma unroll
    for (int i = 0; i < 16; ++i) A[i] = imax(A[i], B[15 - i]);
    bitonic_merge16_desc(A);
}
DI void route_scores(Frame& F, int tok, int hd, int half, int r, int hh, int (&tk)[16]) {
    bf16x8 qf[8];
    { const bf16* qp = F.QP + ((size_t)hd * M + tok) * PDQ + half * PDH + 8 * hh;
#pragma unroll
      for (int ks = 0; ks < 8; ++ks) qf[ks] = *(const GAS bf16x8*)(qp + 16 * ks); }
    int top[16];
#pragma unroll
    for (int c = 0; c < 4; ++c) {
        f32x16 s;
#pragma unroll
        for (int i = 0; i < 16; ++i) s[i] = 0.f;
        const bf16* kp = F.SK + (size_t)half * NKEYS * PDH + (size_t)(32 * c + r) * PDH + 8 * hh;
#pragma unroll
        for (int ks = 0; ks < 8; ++ks) { const bf16x8 kf = *(const GAS bf16x8*)(kp + 16 * ks); s = MFMA32(kf, qf[ks], s); }
        int kk[16];
#pragma unroll
        for (int i = 0; i < 16; ++i) kk[i] = (f2key(s[i]) & ~127) | (32 * c + (i & 3) + 8 * (i >> 2) + 4 * hh);
        sort16_desc(kk);
        if (c == 0) {
#pragma unroll
            for (int i = 0; i < 16; ++i) top[i] = kk[i];
        } else merge_top16(top, kk);
        __builtin_amdgcn_sched_barrier(0);
    }
    int pk[16];
#pragma unroll
    for (int i = 0; i < 16; ++i) pk[i] = __shfl_xor(top[i], 32);
    merge_top16(top, pk);
#pragma unroll
    for (int i = 0; i < 16; ++i) tk[i] = top[i];
}
struct CandTab { int a[50], b[50]; };
DI void route_task(Frame& F, LAS unsigned* wl, int tt, int hd) {
    const int lane = F.lane, r = lane & 31, hh = lane >> 5;
    const int tok = 32 * tt + r;
    int t1[16], t2[16];
    route_scores(F, tok, hd, 0, r, hh, t1);
    route_scores(F, tok, hd, 1, r, hh, t2);
    float v1[16], v2[16];
#pragma unroll
    for (int k = 0; k < 16; ++k) { wl[k * 64 + lane] = (unsigned)(t1[k] & 127); wl[(16 + k) * 64 + lane] = (unsigned)(t2[k] & 127);
        v1[k] = key2f(t1[k] & ~127); v2[k] = key2f(t2[k] & ~127); }
    int top[16];
#pragma unroll
    for (int bb = 0; bb < 16; ++bb) top[bb] = (f2key(v1[0] + v2[bb]) & ~255) | (15 - bb);
#pragma unroll
    for (int a = 1; a < 8; ++a) {
        int row[16];
#pragma unroll
        for (int bb = 0; bb < 16; ++bb) row[bb] = ((a + 1) * (bb + 1) <= 16) ? ((f2key(v1[a] + v2[bb]) & ~255) | (a << 4) | (15 - bb)) : (int)0x80000000;
        merge_top16(top, row);
    }
    { int row[16];
#pragma unroll
      for (int q = 0; q < 16; ++q) row[q] = (q < 8) ? ((f2key(v1[8 + q] + v2[0]) & ~255) | ((8 + q) << 4) | 15) : (int)0x80000000;
      merge_top16(top, row); }
    float fv[16]; int fe[16];
#pragma unroll
    for (int k = 0; k < 16; ++k) { const int a = (top[k] >> 4) & 15, bb = 15 - (top[k] & 15);
        fe[k] = (int)(wl[a * 64 + lane] * NKEYS + wl[(16 + bb) * 64 + lane]); fv[k] = key2f(top[k] & ~255); }
    float ev[16], sum = 0.f;
#pragma unroll
    for (int k = 0; k < 16; ++k) { ev[k] = __expf(fv[k] - fv[0]); sum += ev[k]; }
    const float inv = 1.f / sum;
    if (hh == 0) {
        GAS v4u* ip = (GAS v4u*)(F.IDX + (size_t)tok * (PH * PK) + hd * PK); GAS f32x4* gp = (GAS f32x4*)(F.GW + (size_t)tok * (PH * PK) + hd * PK);
#pragma unroll
        for (int q = 0; q < 2; ++q) { v4u iv; iv.x = (unsigned)fe[8 * q] | ((unsigned)fe[8 * q + 1] << 16); iv.y = (unsigned)fe[8 * q + 2] | ((unsigned)fe[8 * q + 3] << 16);
            iv.z = (unsigned)fe[8 * q + 4] | ((unsigned)fe[8 * q + 5] << 16); iv.w = (unsigned)fe[8 * q + 6] | ((unsigned)fe[8 * q + 7] << 16); ip[q] = iv; }
#pragma unroll
        for (int q = 0; q < 4; ++q) {
            f32x4 gv; gv.x = ev[4 * q] * inv; gv.y = ev[4 * q + 1] * inv; gv.z = ev[4 * q + 2] * inv; gv.w = ev[4 * q + 3] * inv; gp[q] = gv; }
    }
}
DI void route_phase(Frame& F) {
    LAS unsigned* wl = (LAS unsigned*)(F.lds + RING_OFF + F.wave * 16384);
    const int gw = F.vcu * NWAVES + F.wave, NGW = F.G * NWAVES;
    for (int wt = gw; wt < (M / 32) * PH; wt += NGW) route_task(F, wl, wt >> 3, wt & 7);
}

DI float gelu_erf(float v) { return 0.5f * v * (1.f + erff(v * 0.70710678118654752f)); }
DI void slice_partition(Frame& F, int& x, int& sstep, int& t_lo, int& t_hi) {
    int rank, nrank;
    if ((F.G & 7) == 0) { x = blockIdx.x & 7; rank = blockIdx.x >> 3; nrank = F.G >> 3; sstep = 8; } else { x = 0; rank = blockIdx.x; nrank = F.G; sstep = 1; }
    t_lo = (int)((long)M * rank / nrank); t_hi = (int)((long)M * (rank + 1) / nrank);
}
DI long mk64(unsigned lo, unsigned hi) { return (long)(((unsigned long long)hi << 32) | lo); }
#ifndef GATHER_AUX
#define GATHER_AUX 0
#endif
DI __amdgpu_buffer_rsrc_t slice_rsrc(const unsigned char* base) { return __builtin_amdgcn_make_buffer_rsrc((void*)base, 0, NEXP * SLB, 0x00020000); }
struct UTok { v4u g[16]; v4u h[2][2]; };
DI void u_idx(Frame& F, int t, int gq, v4u (&ei)[2]) {
#pragma unroll
    for (int q = 0; q < 2; ++q) ei[q] = *(const GAS v4u*)(F.IDX + (size_t)t * 128 + 16 * gq + 8 * q);
}
DI unsigned id_of(const v4u (&ei)[2], int i) { const unsigned w = ei[i >> 3][(i >> 1) & 3]; return (i & 1) ? (w >> 16) : (w & 0xffffu); }
DI void u_load(Frame& F, __amdgpu_buffer_rsrc_t rs, unsigned suboff, int s, int kg, int t, const v4u (&ei)[2], UTok& T) {
#pragma unroll
    for (int i = 0; i < 16; ++i) T.g[i] = __builtin_amdgcn_raw_buffer_load_b128(rs, id_of(ei, i) * SLB + suboff, 0, GATHER_AUX);
#pragma unroll
    for (int st = 0; st < 2; ++st) { const GAS unsigned char* hp = (const GAS unsigned char*)(F.H8 + (size_t)t * D + 128 * s + 64 * st + 16 * kg); T.h[st][0] = *(const GAS v4u*)hp; T.h[st][1] = *(const GAS v4u*)(hp + 2048); }
}
DI void tile_stage(LAS unsigned char* wl, int lane, const v4u (&g)[16]) {
    const int gq = lane >> 3, sub = lane & 7;
#pragma unroll
    for (int i = 0; i < 16; ++i) *(LAS v4u*)(wl + (16 * gq + i) * SLB + ((sub ^ ((i >> 1) & 7)) << 4)) = g[i];
}
typedef int i32x8v __attribute__((ext_vector_type(8)));
DI void u_mfma_store(Frame& F, LAS unsigned char* wl, int s, int t, int lane, const v4u (&h)[2][2]) {
    const int n16 = lane & 15, kg = lane >> 4;
    const LAS unsigned char* rb = wl + n16 * SLB;
    const int sw = (n16 >> 1) & 7;
    float d[8];
#pragma unroll
    for (int hd = 0; hd < 8; ++hd) { f32x4 acc0 = {0.f, 0.f, 0.f, 0.f}, acc1 = acc0;
#pragma unroll
        for (int st = 0; st < 2; ++st) { const v4u bq = *(const LAS v4u*)(rb + hd * 16 * SLB + (((4 * st + kg) ^ sw) << 4));
            const i32x8v bb = (i32x8v){(int)bq.x, (int)bq.y, (int)bq.z, (int)bq.w, 0, 0, 0, 0};
            const i32x8v a0 = (i32x8v){(int)h[st][0].x, (int)h[st][0].y, (int)h[st][0].z, (int)h[st][0].w, 0, 0, 0, 0}, a1 = (i32x8v){(int)h[st][1].x, (int)h[st][1].y, (int)h[st][1].z, (int)h[st][1].w, 0, 0, 0, 0};
            acc0 = __builtin_amdgcn_mfma_scale_f32_16x16x128_f8f6f4(a0, bb, acc0, 4  , 4  , 0, 0, 0, 0);
            acc1 = __builtin_amdgcn_mfma_scale_f32_16x16x128_f8f6f4(a1, bb, acc1, 4, 4, 0, 0, 0, 0); }
        d[hd] = acc0[0] + acc1[0] * (1.f / FP4_K2); }
    const float da = kg == 0 ? d[0] : kg == 1 ? d[2] : kg == 2 ? d[4] : d[6], db = kg == 0 ? d[1] : kg == 1 ? d[3] : kg == 2 ? d[5] : d[7];
    LAS float* tw = (LAS float*)wl;
    tw[32 * kg + n16] = da; tw[32 * kg + 16 + n16] = db;
    { const f32x2 pv = *(const LAS f32x2*)(tw + 2 * lane); *(GAS unsigned*)(F.PD + ((size_t)s * M + t) * 128 + 2 * lane) = pkbf(pv.x, pv.y); }
}
DI void peer_u_phase(Frame& F) {
    const int lane = F.lane, gq = lane >> 3, sub = lane & 7, kg = lane >> 4;
    LAS unsigned char* wl = F.lds + RING_OFF + F.wave * 16384;
    int x, sstep, t_lo, t_hi; slice_partition(F, x, sstep, t_lo, t_hi);
    for (int s = x; s < NSLU; s += sstep) {
        const __amdgpu_buffer_rsrc_t ubase = slice_rsrc(F.U8 + (size_t)s * NEXP * SLB); const unsigned suboff = 16u * (unsigned)sub;
        const int t0 = t_lo + F.wave;
        v4u en[2]; UTok T;
        { v4u e0[2]; u_idx(F, t0 < t_hi ? t0 : t_lo, gq, e0); u_load(F, ubase, suboff, s, kg, t0 < t_hi ? t0 : t_lo, e0, T); }
        u_idx(F, t0 + NWAVES < t_hi ? t0 + NWAVES : t_lo, gq, en);
        for (int t = t0; t < t_hi; t += NWAVES) {
            const int t1 = t + NWAVES < t_hi ? t + NWAVES : t_lo, t2 = t + 2 * NWAVES < t_hi ? t + 2 * NWAVES : t_lo;
            tile_stage(wl, lane, T.g);
            v4u hc[2][2];
#pragma unroll
            for (int st = 0; st < 2; ++st) { hc[st][0] = T.h[st][0]; hc[st][1] = T.h[st][1]; }
            u_load(F, ubase, suboff, s, kg, t1, en, T);
            u_idx(F, t2, gq, en);
            u_mfma_store(F, wl, s, t, lane, hc);
        }
    }
}
struct ActIn { unsigned long long q[16]; unsigned long long ev; f32x4 gw; float sh; };
struct ActSc { float su[4], sv[4]; };
DI void act_load_in(const Frame& F, int it, ActIn& I) {
    const int t = it >> 5, j4 = (it & 31) * 4;
    const GAS unsigned long long* p = (const GAS unsigned long long*)(F.PD + (size_t)t * 128 + j4);
#pragma unroll
    for (int s = 0; s < NSLU; ++s) I.q[s] = p[(size_t)s * M * 32];
    I.sh = F.SH[t];
    I.ev = *(const GAS unsigned long long*)(F.IDX + (size_t)t * 128 + j4); I.gw = *(const GAS f32x4*)(F.GW + (size_t)t * 128 + j4);
}
DI void act_load_sc(const Frame& F, const ActIn& I, ActSc& S) {
#pragma unroll
    for (int c = 0; c < 4; ++c) { const int e = (int)((I.ev >> (16 * c)) & 0xffffu); S.su[c] = F.SU[e]; S.sv[c] = F.SV[e]; }
}
DI void act_finish(const Frame& F, int it, const ActIn& I, const ActSc& S) {
    const int t = it >> 5, j4 = (it & 31) * 4;
    f32x4 sum = {0.f, 0.f, 0.f, 0.f};
#pragma unroll
    for (int s = 0; s < NSLU; ++s) { const unsigned lo = (unsigned)I.q[s], hi = (unsigned)(I.q[s] >> 32);
        sum.x += bflo(lo); sum.y += bfhi(lo); sum.z += bflo(hi); sum.w += bfhi(hi); }
    float a[4];
#pragma unroll
    for (int c = 0; c < 4; ++c) a[c] = gelu_erf(sum[c] * I.sh * S.su[c]) * I.gw[c] * S.sv[c];
    float am = fmaxf(fmaxf(__builtin_fabsf(a[0]), __builtin_fabsf(a[1])), fmaxf(__builtin_fabsf(a[2]), __builtin_fabsf(a[3])));
#pragma unroll
    for (int o = 1; o < 32; o <<= 1) am = fmaxf(am, __shfl_xor(am, o));
    const float sc = am > 1e-30f ? am * (1.f / FP4_TOP) : 1.f, inv = am > 1e-30f ? FP4_TOP / am : 0.f;
    unsigned p0, p1; fp4_planes4(a[0] * inv, a[1] * inv, a[2] * inv, a[3] * inv, p0, p1);
    GAS unsigned char* ap = (GAS unsigned char*)(F.ACT8 + (size_t)t * 128) + (j4 >> 1);
    *(GAS unsigned short*)ap = (unsigned short)p0; *(GAS unsigned short*)(ap + 64) = (unsigned short)p1;
    if ((it & 31) == 0) F.SA[t] = sc;
}
DI void peer_act_phase(Frame& F) {
    const int gt = F.vcu * NWAVES * 64 + F.tid, NT = F.G * NWAVES * 64, N = M * 32;
    int it = gt;
    if (it >= N) return;
    ActIn I0, I1, I2; ActSc S0, S1, S2;
    act_load_in(F, it, I0);
    if (it + NT < N) act_load_in(F, it + NT, I1);
    act_load_sc(F, I0, S0);
#define ACT_STEP(Ic, In, In2, Sc, Sn) { if (it + 2 * NT < N) act_load_in(F, it + 2 * NT, In2); if (it + NT < N) act_load_sc(F, In, Sn); act_finish(F, it, Ic, Sc); if (it + NT >= N) break; it += NT; }
    while (true) {
        ACT_STEP(I0, I1, I2, S0, S1)
        ACT_STEP(I1, I2, I0, S1, S2)
        ACT_STEP(I2, I0, I1, S2, S0)
    }
#undef ACT_STEP
}
struct VTok { v4u g[16]; v4u a[2]; f32x4 gv; unsigned long long dl; float sa; };
DI void v_load(Frame& F, __amdgpu_buffer_rsrc_t rs, unsigned suboff, int s, int lane, int t, const v4u (&ei)[2], VTok& T) {
    const int kg = lane >> 4;
#pragma unroll
    for (int i = 0; i < 16; ++i) T.g[i] = __builtin_amdgcn_raw_buffer_load_b128(rs, id_of(ei, i) * SLB + suboff, 0, GATHER_AUX);
    { const int col = 256 * s + 4 * lane;
      T.gv = *(const GAS f32x4*)(F.MOD + (size_t)(t / SEQ) * MODW + 5 * D + col);
      T.dl = *(const GAS unsigned long long*)(F.DELTA + (size_t)t * D + col); T.sa = F.SA[t]; }
#pragma unroll
    for (int pl = 0; pl < 2; ++pl) T.a[pl] = *(const GAS v4u*)(F.ACT8 + (size_t)t * 128 + 64 * pl + 16 * kg);
}
DI void v_mfma_store(Frame& F, LAS unsigned char* wl, int s, int t, int lane, const v4u (&av)[2], f32x4 gv, unsigned long long dl, float sa) {
    const int n16 = lane & 15, kg = lane >> 4;
    const LAS unsigned char* rb = wl + (32 * kg + n16) * SLB;
    const int sw = (n16 >> 1) & 7;
    const i32x8v a0 = (i32x8v){(int)av[0].x, (int)av[0].y, (int)av[0].z, (int)av[0].w, 0, 0, 0, 0}, a1 = (i32x8v){(int)av[1].x, (int)av[1].y, (int)av[1].z, (int)av[1].w, 0, 0, 0, 0};
    float y[16];
#pragma unroll
    for (int cb = 0; cb < 16; ++cb) { const f32x4 z4 = {0.f, 0.f, 0.f, 0.f};
        const int off = (((cb >> 1) ^ sw) << 4) + 8 * (cb & 1);
        const i32x2 b0 = __builtin_amdgcn_ds_read_tr4_b64_v2i32((LAS i32x2*)(rb + off)), b1 = __builtin_amdgcn_ds_read_tr4_b64_v2i32((LAS i32x2*)(rb + 16 * SLB + off));
        const i32x8v bb = (i32x8v){b0[0], b0[1], b1[0], b1[1], 0, 0, 0, 0};
        const f32x4 acc0 = __builtin_amdgcn_mfma_scale_f32_16x16x128_f8f6f4(a0, bb, z4, 4, 4, 0, 0, 0, 0), acc1 = __builtin_amdgcn_mfma_scale_f32_16x16x128_f8f6f4(a1, bb, z4, 4, 4, 0, 0, 0, 0);
        y[cb] = acc0[0] + acc1[0] * (1.f / FP4_K2); }
    LAS float* tw = (LAS float*)wl;
#pragma unroll
    for (int q = 0; q < 4; ++q) { const float yq = kg == 0 ? y[q] : kg == 1 ? y[4 + q] : kg == 2 ? y[8 + q] : y[12 + q]; tw[(4 * kg + q) * 16 + n16] = yq; }
    const f32x4 yy = *(const LAS f32x4*)(tw + 4 * lane);
    const int col = 256 * s + 4 * lane;
    const unsigned dlo = (unsigned)dl, dhi = (unsigned)(dl >> 32);
    const float za = bflo(dlo) + gv.x * (sa * yy.x), zb = bfhi(dlo) + gv.y * (sa * yy.y), zc = bflo(dhi) + gv.z * (sa * yy.z), zd = bfhi(dhi) + gv.w * (sa * yy.w);
    *(GAS unsigned long long*)(F.Z + (size_t)t * D + col) = (unsigned long long)pkbf(za, zb) | ((unsigned long long)pkbf(zc, zd) << 32);
    const float ss = wave_sum(za * za + zb * zb + zc * zc + zd * zd);
    if (lane == 0) F.SSQ[(size_t)s * M + t] = ss;
}
DI void peer_v_phase(Frame& F) {
    int lane_o = F.lane; asm volatile("" : "+v"(lane_o));
    const int lane = lane_o, gq = lane >> 3, sub = lane & 7;
    LAS unsigned char* wl = F.lds + RING_OFF + F.wave * 16384;
    int x, sstep, t_lo, t_hi; slice_partition(F, x, sstep, t_lo, t_hi);
    for (int s = x; s < NSLU; s += sstep) {
        const __amdgpu_buffer_rsrc_t vbase = slice_rsrc(F.V8 + (size_t)s * NEXP * SLB); const unsigned suboff = 16u * (unsigned)sub;
        const int t0 = t_lo + F.wave;
        v4u en[2]; VTok T;
        { v4u e0[2]; u_idx(F, t0 < t_hi ? t0 : t_lo, gq, e0); v_load(F, vbase, suboff, s, lane, t0 < t_hi ? t0 : t_lo, e0, T); }
        u_idx(F, t0 + NWAVES < t_hi ? t0 + NWAVES : t_lo, gq, en);
        for (int t = t0; t < t_hi; t += NWAVES) {
            const int t1 = t + NWAVES < t_hi ? t + NWAVES : t_lo, t2 = t + 2 * NWAVES < t_hi ? t + 2 * NWAVES : t_lo;
            tile_stage(wl, lane, T.g);
            v4u ac[2];
#pragma unroll
            for (int pl = 0; pl < 2; ++pl) ac[pl] = T.a[pl];
            const f32x4 gc = T.gv; const unsigned long long dc = T.dl; const float sc = T.sa;
            v_load(F, vbase, suboff, s, lane, t1, en, T);
            u_idx(F, t2, gq, en);
            v_mfma_store(F, wl, s, t, lane, ac, gc, dc, sc);
        }
    }
}
struct ZRow { unsigned long long r[16]; };
DI void z_load(const Frame& F, int t, int lane, ZRow& R) {
    const GAS unsigned long long* zp = (const GAS unsigned long long*)(F.Z + (size_t)t * D) + lane;
#pragma unroll
    for (int j = 0; j < 16; ++j) R.r[j] = zp[64 * j];
}
DI void z_store(const Frame& F, int t, int lane, float rstd, const f32x4 (&gf)[16], const ZRow& R) {
    GAS f32x4* op = (GAS f32x4*)(F.out + (size_t)t * D) + lane;
#pragma unroll
    for (int j = 0; j < 16; ++j) { const unsigned lo = (unsigned)R.r[j], hi = (unsigned)(R.r[j] >> 32);
        f32x4 o; o.x = bflo(lo) * rstd * gf[j].x; o.y = bfhi(lo) * rstd * gf[j].y; o.z = bflo(hi) * rstd * gf[j].z; o.w = bfhi(hi) * rstd * gf[j].w; op[64 * j] = o; }
}
DI void final_norm_phase(Frame& F) {
    LAS float* rs = (LAS float*)(F.lds + RING_OFF);
    const int lane = F.lane;
    f32x4 gf[16];
    { const GAS f32x4* gp = (const GAS f32x4*)F.g_final + lane;
#pragma unroll
      for (int j = 0; j < 16; ++j) gf[j] = gp[64 * j]; }
    for (int tb = F.vcu; tb < M / 64; tb += F.G) {
        const int t0 = tb * 64 + F.wave * 8;
        ZRow Ra, Rb;
        z_load(F, t0, lane, Ra);
        __syncthreads();
        if (F.tid < 64) { const int t = tb * 64 + F.tid; float ss = 0.f;
#pragma unroll
            for (int s = 0; s < NSLU; ++s) ss += F.SSQ[(size_t)s * M + t];
            rs[F.tid] = 1.f / sqrtf(ss * (1.f / D) + EPS); }
        __syncthreads();
        for (int i = 0; i < 8; i += 2) {
            z_load(F, t0 + i + 1, lane, Rb);
            z_store(F, t0 + i, lane, rs[F.wave * 8 + i], gf, Ra);
            if (i + 2 < 8) z_load(F, t0 + i + 2, lane, Ra);
            z_store(F, t0 + i + 1, lane, rs[F.wave * 8 + i + 1], gf, Rb);
        }
    }
}
struct Args { const float* in[17]; float* out; unsigned char* ws; int ph_lo, ph_hi, li, pad; };
__global__ void __launch_bounds__(NWAVES * 64, 2) peer_block_fwd(Args args) {
    extern __shared__ __attribute__((aligned(16))) unsigned char lds[];
    Frame F;
    F.lds = (LAS unsigned char*)lds;
    F.MISC = (volatile LAS unsigned*)(F.lds + MISC_OFF);
    F.tid = threadIdx.x; F.lane = F.tid & 63; F.wave = __builtin_amdgcn_readfirstlane(F.tid >> 6);
    F.G = gridDim.x; { const int bx = blockIdx.x; F.vcu = (F.G % 8 == 0) ? (bx % 8) * (F.G / 8) + bx / 8 : bx; }
    unsigned char* ws = args.ws;
    F.ctl = (gu32*)(ws + WS_CTL);
    F.x = args.in[0]; F.c = args.in[1]; F.w_ada = args.in[2]; F.b_ada = args.in[3]; F.g1 = args.in[4]; F.w_in = args.in[5]; F.g_ah = args.in[6]; F.w_pool = args.in[7]; F.s_pool = args.in[8];
    F.w_out = args.in[9]; F.g2 = args.in[10]; F.w_query = args.in[11]; F.sk1 = args.in[12]; F.sk2 = args.in[13]; F.u_exp = args.in[14]; F.v_exp = args.in[15]; F.g_final = args.in[16];
    F.out = args.out;
    F.MOD = (float*)(ws + WS_MOD); F.SK = (bf16*)(ws + WS_SK); F.WPS = (bf16*)(ws + WS_WPT); F.WQT = (bf16*)(ws + WS_WQT); F.WMIXT = (bf16*)(ws + WS_WOUTT); F.WINT = (bf16*)(ws + WS_WINT);
    F.H = (bf16*)(ws + WS_H); F.PROJ = (bf16*)(ws + WS_PROJ); F.CAT = (bf16*)(ws + WS_CAT); F.WOP = (bf16*)(ws + WS_DP); F.QP = (bf16*)(ws + WS_QP); F.DELTA = (bf16*)(ws + WS_X1);
    F.IDX = (unsigned short*)(ws + WS_IDX); F.GW = (float*)(ws + WS_GW);
    F.U8 = ws + WS_U8; F.V8 = ws + WS_V8; F.SU = (float*)(ws + WS_SU); F.SV = (float*)(ws + WS_SV);
    F.CAT8 = ws + WS_CAT8; F.WMIX8 = ws + WS_WMIX8; F.SCA = (float*)(ws + WS_SCA); F.SCB = (float*)(ws + WS_SCB);
    F.H8 = ws + WS_H8; F.SH = (float*)(ws + WS_SH); F.PD = (bf16*)(ws + WS_PD); F.ACT8 = ws + WS_ACT; F.SA = (float*)(ws + WS_ACT + 4 * MiB); F.SSQ = (float*)(ws + WS_SSQ); F.Z = (bf16*)(ws + WS_Z);
    for (int u = F.tid; u < (LDS_BYTES - LDSCTL_OFF) / 4; u += NWAVES * 64) ((LAS unsigned*)(F.lds + LDSCTL_OFF))[u] = 0u;
    __syncthreads();
    XcdBarrier bar; bar.bar = (unsigned*)(F.ctl + CW_BAR); bar.x = 0; bar.st = nullptr;
    if (N_LAUNCHES == 1) bar = xcd_barrier_post((unsigned*)(F.ctl + CW_BAR), F.MISC + 8);
    const int lo = args.ph_lo, hi = args.ph_hi;
#ifndef PHASE_MASK
#define PHASE_MASK 0x1fff
#endif
#define IN(k) (lo <= (k) && (k) < hi && ((PHASE_MASK >> (k)) & 1))
#define SEAM(k) do { if (IN(k) && IN((k) + 1)) xcd_barrier(bar); } while (0)
#ifndef PROBE_REP
#define PROBE_REP 0
#endif
#define REPS(k) (((PROBE_REP >> (k)) & 1) ? 2 : 1)
    const int NOGRP = 1 << 30;

    if (IN(0)) for (int rep_ = 0; rep_ < REPS(0); ++rep_) { if (rep_) xcd_barrier(bar); ph0_prologue(F); SEAM(0); }
    if (IN(1)) for (int rep_ = 0; rep_ < REPS(1); ++rep_) { if (rep_) xcd_barrier(bar);
        {
            pg8::Gemm g{F.WOP, F.WPS, D, DPOOL, PGRP, 2, (size_t)PGRP * 2, LDP, PGRP}; pg8::StaticOrder S; S.init(D, DPOOL, F.G, (int)blockIdx.x);
            pg8::EpiBf16<0> E{F.WMIXT + DATTN, LDK, nullptr, 0, 0, 1.f};
            pg8::gemm_phase<pg8::EpiBf16<0>, pg8::StaticOrder, true, true>(F.lds + RING_OFF, g, S, E);
        }
        norm_phase<false>(F, F.x, F.g1, 0, 1, F.H); SEAM(1); }
    if (IN(2)) for (int rep_ = 0; rep_ < REPS(2); ++rep_) { if (rep_) xcd_barrier(bar);
        pg8::Gemm g{F.H, F.WINT, M, NPROJ, D, NOGRP, 0, LDK, LDK}; pg8::StaticOrder S; S.init(M, NPROJ, F.G, (int)blockIdx.x);
        pg8::EpiProjHM E{F.PROJ, F.PROJ + (size_t)3 * M * DATTN, SEQ, NH, HD, DATTN, DPOOL};
        pg8::gemm_phase<pg8::EpiProjHM, pg8::StaticOrder, true, true>(F.lds + RING_OFF, g, S, E);
        SEAM(2);
    }
    if (IN(3)) for (int rep_ = 0; rep_ < REPS(3); ++rep_) { if (rep_) xcd_barrier(bar); mix_weight_fp8(F); pool_diff_phase(F); attn_phase(F);
#if defined(PROBE_POOL2)
        pool_diff_phase(F);
#endif
#if defined(PROBE_ATTN2)
        attn_phase(F);
#endif
        if (IN(3) && IN(5)) xcd_barrier(bar); }
    if (IN(5)) for (int rep_ = 0; rep_ < REPS(5); ++rep_) { if (rep_) xcd_barrier(bar);
        pg8::EpiG8WResid E{F.x, F.DELTA, D, F.MOD + 2 * D, MODW, SEQ, nullptr, 1.f / CAT_SCALE, F.SCB};
        pg8::gemm8w_phase<pg8::EpiG8WResid>(F.lds + RING_OFF, F.CAT8, F.WMIX8, M, D, D, D, D, F.G, (int)blockIdx.x, E);
        __syncthreads();
        SEAM(5);
    }
    if (IN(6)) for (int rep_ = 0; rep_ < REPS(6); ++rep_) { if (rep_) xcd_barrier(bar); norm_phase<true>(F, nullptr, F.g2, 3, 4, F.H); SEAM(6); }
    if (IN(7)) for (int rep_ = 0; rep_ < REPS(7); ++rep_) { if (rep_) xcd_barrier(bar);
        pg8::Gemm g{F.H, F.WQT, M, NQ, D, NOGRP, 0, LDK, LDK}; pg8::StaticOrder S; S.init(M, NQ, F.G, (int)blockIdx.x);
        pg8::EpiBf16<0> E{F.QP, PDQ, nullptr, PDQ, (size_t)M * PDQ, 1.f};
        pg8::gemm_phase<pg8::EpiBf16<0>, pg8::StaticOrder, false, true>(F.lds + RING_OFF, g, S, E);
        SEAM(7);
    }
    if (IN(8)) for (int rep_ = 0; rep_ < REPS(8); ++rep_) { if (rep_) xcd_barrier(bar); route_phase(F); SEAM(8); }
    if (IN(9)) for (int rep_ = 0; rep_ < REPS(9); ++rep_) { if (rep_) xcd_barrier(bar); peer_u_phase(F); SEAM(9); }
    if (IN(10)) for (int rep_ = 0; rep_ < REPS(10); ++rep_) { if (rep_) xcd_barrier(bar); peer_act_phase(F); SEAM(10); }
    if (IN(11)) for (int rep_ = 0; rep_ < REPS(11); ++rep_) { if (rep_) xcd_barrier(bar); peer_v_phase(F); SEAM(11); }
    if (IN(12)) for (int rep_ = 0; rep_ < REPS(12); ++rep_) { if (rep_) xcd_barrier(bar); final_norm_phase(F); }
#undef IN
#undef SEAM
}

extern "C" void kernel_launch(void* const* d_in, const int* in_sizes, int n_in, void* d_out, int out_size, void* d_ws, size_t ws_size, hipStream_t stream) {
    static int grid = 0;
    if (grid == 0) {
        if (n_in != 17 || in_sizes[0] != M * D || out_size != M * D || ws_size < WS_END) { fprintf(stderr, "kernel_launch: built for 17 inputs, x/out of %d floats, >= %zu bytes of workspace; got n_in %d, in0 %d, out %d, ws %zu; nothing launched\n", M * D, (size_t)WS_END, n_in, n_in > 0 ? in_sizes[0] : -1, out_size, ws_size); grid = -1; return; }
        int dev = 0, cus = 0, per_cu = 0;
        if (hipGetDevice(&dev) != hipSuccess || hipDeviceGetAttribute(&cus, hipDeviceAttributeMultiprocessorCount, dev) != hipSuccess) { fprintf(stderr, "kernel_launch: hipGetDevice / hipDeviceGetAttribute failed\n"); grid = -1; return; }
        if (hipFuncSetAttribute((const void*)peer_block_fwd, hipFuncAttributeMaxDynamicSharedMemorySize, LDS_BYTES) != hipSuccess) { fprintf(stderr, "kernel_launch: hipFuncSetAttribute failed\n"); grid = -1; return; }
        if (hipOccupancyMaxActiveBlocksPerMultiprocessor(&per_cu, (const void*)peer_block_fwd, NWAVES * 64, LDS_BYTES) != hipSuccess || per_cu < 1)
            fprintf(stderr, "kernel_launch: note: occupancy query reports %d workgroups per CU\n", per_cu);
        (void)hipGetLastError();
        grid = cus;
    }
    if (grid < 0) return;
    if (hipMemsetAsync((char*)d_ws + WS_CTL, 0, CTL_ZERO_BYTES, stream) != hipSuccess) { fprintf(stderr, "kernel_launch: hipMemsetAsync failed\n"); return; }
    Args a{};
    for (int i = 0; i < 17; ++i) a.in[i] = (const float*)d_in[i];
    a.out = (float*)d_out; a.ws = (unsigned char*)d_ws;
    for (int li = 0; li < N_LAUNCHES; ++li) {
        a.ph_lo = (N_LAUNCHES == 1) ? 0 : li; a.ph_hi = (N_LAUNCHES == 1) ? NPHASE : li + 1; a.li = li;
        hipLaunchKernelGGL(peer_block_fwd, dim3(grid), dim3(NWAVES * 64), LDS_BYTES, stream, a);
        const hipError_t le = hipPeekAtLastError();
        if (le != hipSuccess) { fprintf(stderr, "kernel_launch: launch %d failed: %s\n", li, hipGetErrorName(le)); break; }
    }
}
```
